# Optimizing an MI355X kernel written in HIP

```python
import math
import jax, jax.numpy as jnp
from jax import lax
import numpy as np

D_MODEL = 1024
BATCH = 8
SEQ = 2048
DEPTH = 2

CHUNK = 64
N_MEM = 256
D_MIX = D_MODEL
RET_HEADS = 4
RET_HD = 128
RET_WIDTH = RET_HEADS * RET_HD
SB_HEADS = 8
SB_HD = 64
SB_WIDTH = SB_HEADS * SB_HD
IN_COLS = 4 * RET_WIDTH + 3 * SB_WIDTH
X_HEADS = 4
X_HD = D_MODEL // X_HEADS
D_FF = 4 * D_MODEL
SB_BLOCK = 128
EPS = 1e-6
ROPE_BASE = 10000.0

kernel_name = "hymba_retention_stickbreaking_block"


def _rmsnorm(x, g):
    xf = x.astype(jnp.float32)
    y = xf * lax.rsqrt(jnp.mean(xf * xf, axis=-1, keepdims=True) + EPS)
    return (y * g.astype(jnp.float32)).astype(x.dtype)


def _rotary(x):
    s, hd = x.shape[1], x.shape[-1]
    half = hd // 2
    inv = 1.0 / (ROPE_BASE ** jnp.linspace(0.0, 1.0, half, dtype=jnp.float32))
    ang = jnp.arange(s, dtype=jnp.float32)[:, None] * inv[None, :]
    cos = jnp.cos(ang)[None, :, None, :]
    sin = jnp.sin(ang)[None, :, None, :]
    xf = x.astype(jnp.float32)
    x1, x2 = xf[..., :half], xf[..., half:]
    return jnp.concatenate([x1 * cos - x2 * sin, x1 * sin + x2 * cos], axis=-1).astype(x.dtype)


def _retention(q, k, v):
    b, s, h, d = q.shape
    nc = s // CHUNK
    f32 = jnp.float32
    log_gamma = jnp.log1p(-jnp.exp2(-5.0 - jnp.arange(h, dtype=f32)))
    qf = q.astype(f32).reshape(b, nc, CHUNK, h, d)
    kf = k.astype(f32).reshape(b, nc, CHUNK, h, d) * (d ** -0.5)
    vf = v.astype(f32).reshape(b, nc, CHUNK, h, d)
    idx = jnp.arange(CHUNK, dtype=f32)
    dist = jnp.abs(idx[:, None] - idx[None, :])
    dmask = jnp.exp(log_gamma[:, None, None] * dist)
    scores = jnp.einsum('bnihd,bnjhd->bnhij', qf, kf) * dmask
    o_intra = jnp.einsum('bnhij,bnjhe->bnihe', scores, vf)
    k_dec = jnp.exp(log_gamma[None, :] * (CHUNK - 1.0 - idx)[:, None])
    u = jnp.einsum('bnjhd,bnjhe->nbhde', kf * k_dec[:, :, None], vf)
    chunk_decay = jnp.exp(log_gamma * CHUNK)[None, :, None, None]

    def step(state, u_c):
        return state * chunk_decay + u_c, state

    _, s_before = lax.scan(step, jnp.zeros_like(u[0]), u)
    q_dec = jnp.exp(log_gamma[None, :] * (idx + 1.0)[:, None])
    o_inter = jnp.einsum('bnihd,nbhde->bnihe', qf * q_dec[:, :, None], s_before)
    return (o_intra + o_inter).reshape(b, s, h, d)


def _stick_breaking(q, k, v):
    b, s, h, d = q.shape
    scale = d ** -0.5
    outs = []
    for blk in range(s // SB_BLOCK):
        q0 = blk * SB_BLOCK
        end = q0 + SB_BLOCK
        qb = q[:, q0:end].astype(jnp.float32)
        kb = k[:, :end].astype(jnp.float32)
        vb = v[:, :end].astype(jnp.float32)
        z = jnp.einsum('bthd,bshd->bhts', qb, kb) * scale
        t_idx = q0 + jnp.arange(SB_BLOCK)[:, None]
        s_idx = jnp.arange(end)[None, :]
        strict = s_idx < t_idx
        log_beta = jax.nn.log_sigmoid(z)
        log_1m = jnp.where(strict, jax.nn.log_sigmoid(-z), 0.0)
        after = lax.cumsum(log_1m, axis=3, reverse=True) - log_1m
        a = jnp.where(strict, jnp.exp(log_beta + after), 0.0)
        outs.append(jnp.einsum('bhts,bshd->bthd', a, vb))
    return jnp.concatenate(outs, axis=1)


def setup_inputs(seed: int = 0) -> dict:
    key = jax.random.key(seed)
    ks = jax.random.split(key, 20)
    f32 = jnp.float32

    def w(k, shape, fan_in, gain=1.0):
        return jax.random.normal(k, shape, f32) * (gain * fan_in ** -0.5)

    def g(k, shape):
        return 1.0 + 0.02 * jax.random.normal(k, shape, f32)

    return {
        "x": jax.random.normal(ks[0], (BATCH, SEQ, D_MODEL), f32),
        "mem": jax.random.normal(ks[1], (BATCH, N_MEM, D_MODEL), f32),
        "g_mix": g(ks[2], (DEPTH, D_MODEL)),
        "w_in": w(ks[3], (DEPTH, D_MODEL, IN_COLS), D_MODEL),
        "g_ret_out": g(ks[4], (DEPTH, RET_HEADS, RET_HD)),
        "g_sb_out": g(ks[5], (DEPTH, SB_WIDTH)),
        "w_mix_out": w(ks[6], (DEPTH, D_MIX, D_MODEL), D_MIX, 0.5),
        "g_cross": g(ks[7], (DEPTH, D_MODEL)),
        "g_mem": g(ks[8], (DEPTH, D_MODEL)),
        "w_xq": w(ks[9], (DEPTH, D_MODEL, D_MODEL), D_MODEL),
        "w_xkv": w(ks[10], (DEPTH, D_MODEL, 2 * D_MODEL), D_MODEL),
        "g_qn": g(ks[11], (DEPTH, X_HD)),
        "g_kn": g(ks[12], (DEPTH, X_HD)),
        "w_xo": w(ks[13], (DEPTH, D_MODEL, D_MODEL), D_MODEL, 0.5),
        "g_mlp": g(ks[14], (DEPTH, D_MODEL)),
        "w_up": w(ks[15], (DEPTH, D_MODEL, D_FF), D_MODEL),
        "w_down": w(ks[16], (DEPTH, D_FF, D_MODEL), D_FF, 0.5),
    }


def reference(x, mem, g_mix, w_in, g_ret_out, g_sb_out, w_mix_out, g_cross, g_mem,
              w_xq, w_xkv, g_qn, g_kn, w_xo, g_mlp, w_up, w_down):
    b, s, _ = x.shape
    m = mem.shape[1]
    splits = [RET_WIDTH, 2 * RET_WIDTH, 3 * RET_WIDTH, 4 * RET_WIDTH,
              4 * RET_WIDTH + SB_WIDTH, 4 * RET_WIDTH + 2 * SB_WIDTH]
    for l in range(DEPTH):
        h = _rmsnorm(x, g_mix[l])
        proj = h @ w_in[l]
        rq, rk, rv, rg, sq, sk, sv = jnp.split(proj, splits, axis=-1)
        rq = _rotary(rq.reshape(b, s, RET_HEADS, RET_HD))
        rk = _rotary(rk.reshape(b, s, RET_HEADS, RET_HD))
        rv = rv.reshape(b, s, RET_HEADS, RET_HD)
        o_ret = _rmsnorm(_retention(rq, rk, rv), g_ret_out[l])
        o_ret = o_ret.reshape(b, s, RET_WIDTH).astype(x.dtype) * jax.nn.silu(rg)
        o_sb = _stick_breaking(sq.reshape(b, s, SB_HEADS, SB_HD),
                               sk.reshape(b, s, SB_HEADS, SB_HD),
                               sv.reshape(b, s, SB_HEADS, SB_HD))
        o_sb = _rmsnorm(o_sb.reshape(b, s, SB_WIDTH), g_sb_out[l]).astype(x.dtype)
        x = x + jnp.concatenate([o_ret, o_sb], axis=-1) @ w_mix_out[l]

        hq = _rmsnorm(x, g_cross[l])
        mn = _rmsnorm(mem, g_mem[l])
        q = _rmsnorm((hq @ w_xq[l]).reshape(b, s, X_HEADS, X_HD), g_qn[l])
        kv = mn @ w_xkv[l]
        k, v = jnp.split(kv, 2, axis=-1)
        k = _rmsnorm(k.reshape(b, m, X_HEADS, X_HD), g_kn[l])
        v = v.reshape(b, m, X_HEADS, X_HD)
        sc = jnp.einsum('bthd,bmhd->bhtm', q, k).astype(jnp.float32) * (X_HD ** -0.5)
        p = jax.nn.softmax(sc, axis=-1).astype(v.dtype)
        o = jnp.einsum('bhtm,bmhd->bthd', p, v).reshape(b, s, D_MODEL)
        x = x + o @ w_xo[l]

        hm = _rmsnorm(x, g_mlp[l])
        x = x + jnp.square(jax.nn.relu(hm @ w_up[l])) @ w_down[l]
    return x
```

```cpp
#include <hip/hip_runtime.h>
#include <hip/hip_cooperative_groups.h>
#include <cstdio>
#include <cstdint>
namespace cg = cooperative_groups;

#define LAS __attribute__((address_space(3)))
typedef unsigned short bf16;
typedef short bf16x8 __attribute__((ext_vector_type(8)));
typedef short s16x4 __attribute__((ext_vector_type(4)));
typedef float f32x2 __attribute__((ext_vector_type(2)));
typedef float f32x4 __attribute__((ext_vector_type(4)));
typedef float f32x16 __attribute__((ext_vector_type(16)));
typedef unsigned u32x2 __attribute__((ext_vector_type(2)));
typedef unsigned u32x4 __attribute__((ext_vector_type(4)));
typedef __bf16 bf16x2_t __attribute__((ext_vector_type(2)));

constexpr int T_TOK = 16384, DM = 1024, SEQ = 2048, NB = 8, NMEM = 256, MROWS = NB * NMEM, INC = 3584, FF = 4096;
constexpr float EPS = 1e-6f;
constexpr size_t MiB = 1u << 20;
constexpr size_t WS_W = 0, W_LAYER = 33 * MiB;
constexpr size_t WO_IN = 0, WO_MIX = 3584ull * 2048, WO_XQ = 4608ull * 2048, WO_XKV = 5632ull * 2048, WO_XO = 7680ull * 2048, WO_UP = 8704ull * 2048, WO_DOWN = 12800ull * 2048;
constexpr size_t WS_XB = 66 * MiB;
constexpr size_t WS_R1 = 98 * MiB;
constexpr size_t WS_O = WS_R1 + 32 * MiB;
constexpr size_t WS_KV = 226 * MiB;
constexpr size_t WS_MEMB = 234 * MiB;
constexpr size_t WS_XPART = 238 * MiB;
constexpr size_t WS_QPART = 239 * MiB;
constexpr size_t WS_KPART = 240 * MiB;
constexpr size_t WS_MPART = WS_KPART + 256 * 1024;
constexpr size_t WS_CTR = 241 * MiB;
constexpr size_t WS_PUB = WS_CTR + 32768;
constexpr size_t WS_BAR = WS_CTR + 4096;
constexpr size_t WS_XSS = WS_CTR + 65536;
constexpr size_t WS_MSS = WS_XSS + 7 * 65536;
constexpr size_t WS_CTL_BYTES = 65536 + 7 * 65536 + 8192;
constexpr size_t WS_END = 242 * MiB;
constexpr int LDS_BYTES = 147456, MISC_OFF = 131072;

__device__ __forceinline__ unsigned cvtpk(float lo, float hi) { f32x2 v = {lo, hi}; bf16x2_t b = __builtin_convertvector(v, bf16x2_t); return __builtin_bit_cast(unsigned, b); }
__device__ __forceinline__ float bf2f(unsigned short h) { return __uint_as_float(((unsigned)h) << 16); }
__device__ __forceinline__ float bflo(unsigned w) { return __uint_as_float(w << 16); }
__device__ __forceinline__ float bfhi(unsigned w) { return __uint_as_float(w & 0xffff0000u); }
__device__ __forceinline__ int tid_opaque() { int t = threadIdx.x; asm volatile("" : "+v"(t)); return t; }
__device__ __forceinline__ int crow(int r, int hi) { return (r & 3) + 8 * (r >> 2) + 4 * hi; }
__device__ __forceinline__ float wave_sum(float v) {
#pragma unroll
    for (int o = 1; o < 64; o <<= 1) v += __shfl_xor(v, o);
    return v;
}

template <int OFF> __device__ __forceinline__ void store16_wt(void* p, u32x4 v) { asm volatile("global_store_dwordx4 %0, %1, off offset:%2 sc1\n\ts_nop 1" :: "v"(p), "v"(v), "n"(OFF) : "memory"); }

namespace pg8 {
constexpr int BM = 256, BK = 64, HALF = 128, HTB = HALF * BK * 2, STAGE_BYTES = 8 * HTB, NXCD = 8, WGM = 8;
__host__ __device__ __forceinline__ int lds_byte(int r, int c) { const int st = (r >> 4) * 2 + (c >> 5), rr = r & 15, cc = c & 31, ob = rr * 64 + cc * 2; return st * 1024 + (ob ^ (((ob >> 9) & 1) << 5)); }
__host__ __device__ __forceinline__ void stage_rc(int b, int& R, int& C) { const int st = b / 1024, sb = b % 1024, swz = sb ^ (((sb >> 9) & 1) << 5); R = (st >> 1) * 16 + swz / 64; C = (st & 1) * 32 + (swz % 64) / 2; }
__host__ __device__ __forceinline__ int perm32(int rho) { const int n = rho >> 4, i = rho & 15; return 8 * (i >> 2) + 4 * n + (i & 3); }

struct Unit { int pm, pn; };
struct Gemm { const bf16* A; const bf16* Bt; int M, N, K, lda; int tj; long ajump; const float* hpart; int* pub = nullptr; };

struct StaticOrder {
    int nM, nN, nwg, G, c;
    __host__ __device__ void init(int M, int N, int G_, int c_) { nM = M / BM; nN = N / BM; nwg = nM * nN; G = G_; c = c_; }
    __host__ __device__ bool next(int i, Unit& u) const {
        const long L = (long)i * G + c; if (L >= nwg) return false;
        int wgid = (int)L; { const int q = nwg / NXCD, r = nwg % NXCD, xcd = wgid % NXCD, off = wgid / NXCD; wgid = (xcd < r ? xcd * (q + 1) : r * (q + 1) + (xcd - r) * q) + off; }
        const int nig = WGM * nN, gid = wgid / nig, fm = gid * WGM, gsz = (nM - fm) < WGM ? (nM - fm) : WGM;
        u.pm = fm + ((wgid % nig) % gsz); u.pn = (wgid % nig) / gsz; return true;
    }
};

enum { EM_PROJ = 0, EM_Q = 1, EM_UP = 2, EM_KV = 3 };
template <int MODE> struct EpiB {
    static constexpr bool PERM = true;
    bf16* O; int ldc; const float* part; float* opart;
    __device__ __forceinline__ void operator()(const f32x4 (&acc)[2][2][4][2], const Unit& u, int wr, int wc, int fr, int fq) const {
        const int row0 = u.pm * BM + wr * 64 + fr;
        const int colL = wc * 32 + 8 * fq;
        const int tt = u.pn >> 1;
        float inv[4];
        if (MODE == EM_PROJ) {
#pragma unroll
            for (int e = 0; e < 4; ++e) inv[e] = __builtin_amdgcn_exp2f(-(float)(16 * wc + 4 * fq + e) * (13.287712379549449f / 63.0f)) * 0.15915494309189535f;
        }
        float ssr[2][4];
#pragma unroll
        for (int ai = 0; ai < 2; ++ai)
#pragma unroll
            for (int m = 0; m < 4; ++m) ssr[ai][m] = part[row0 + ai * HALF + m * 16];
#pragma unroll
        for (int ai = 0; ai < 2; ++ai)
#pragma unroll
            for (int m = 0; m < 4; ++m) {
                const int row = row0 + ai * HALF + m * 16;
                const float rstd = rsqrtf(ssr[ai][m] * (1.0f / 1024.0f) + EPS);
                float sn[4], cs[4];
                if (MODE == EM_PROJ && tt <= 1) {
                    const float pos = (float)(row & (SEQ - 1));
#pragma unroll
                    for (int e = 0; e < 4; ++e) { const float rev = __builtin_amdgcn_fractf(pos * inv[e]); sn[e] = __builtin_amdgcn_sinf(rev); cs[e] = __builtin_amdgcn_cosf(rev); }
                }
                float sq = 0.f;
                bf16* rowp = O + (size_t)row * ldc + u.pn * BM + colL;
#pragma unroll
                for (int bj = 0; bj < 2; ++bj) {
                    f32x4 v0 = acc[ai][bj][m][0] * rstd, v1 = acc[ai][bj][m][1] * rstd;
                    if (MODE == EM_PROJ) {
                        if (tt <= 1) {
                            const float sc = (tt == 1) ? 0.08838834764831845f : 1.0f;
                            f32x4 a0, a1;
                            a0[0] = (v0[0] * cs[0] - v0[1] * sn[0]) * sc; a0[1] = (v0[0] * sn[0] + v0[1] * cs[0]) * sc;
                            a0[2] = (v0[2] * cs[1] - v0[3] * sn[1]) * sc; a0[3] = (v0[2] * sn[1] + v0[3] * cs[1]) * sc;
                            a1[0] = (v1[0] * cs[2] - v1[1] * sn[2]) * sc; a1[1] = (v1[0] * sn[2] + v1[1] * cs[2]) * sc;
                            a1[2] = (v1[2] * cs[3] - v1[3] * sn[3]) * sc; a1[3] = (v1[2] * sn[3] + v1[3] * cs[3]) * sc;
                            v0 = a0; v1 = a1;
                        } else if (tt == 3) {
#pragma unroll
                            for (int j = 0; j < 4; ++j) { v0[j] = v0[j] * __builtin_amdgcn_rcpf(1.0f + __builtin_amdgcn_exp2f(-1.4426950408889634f * v0[j])); v1[j] = v1[j] * __builtin_amdgcn_rcpf(1.0f + __builtin_amdgcn_exp2f(-1.4426950408889634f * v1[j])); }
                        } else if (tt == 4) { v0 = v0 * 0.18033688011112042f; v1 = v1 * 0.18033688011112042f; }
                    } else if (MODE == EM_UP) {
#pragma unroll
                        for (int j = 0; j < 4; ++j) { const float a = fmaxf(v0[j], 0.f), b = fmaxf(v1[j], 0.f); v0[j] = a * a; v1[j] = b * b; }
                    } else {
                        sq += (v0[0] * v0[0] + v0[1] * v0[1]) + (v0[2] * v0[2] + v0[3] * v0[3]) + (v1[0] * v1[0] + v1[1] * v1[1]) + (v1[2] * v1[2] + v1[3] * v1[3]);
                    }
                    u32x4 w; w.x = cvtpk(v0[0], v0[1]); w.y = cvtpk(v0[2], v0[3]); w.z = cvtpk(v1[0], v1[1]); w.w = cvtpk(v1[2], v1[3]);
                    if (bj == 0) store16_wt<0>(rowp, w); else store16_wt<HALF * 2>(rowp, w);
                }
                if (MODE == EM_Q || MODE == EM_KV) {
                    sq += __shfl_xor(sq, 16); sq += __shfl_xor(sq, 32);
                    if (fq == 0 && (MODE == EM_Q || u.pn < 4)) opart[(size_t)row * 16 + u.pn * 4 + wc] = sq;
                }
            }
    }
};
template <bool OUT_F32> struct EpiRes {
    static constexpr bool PERM = true;
    float* xout; bf16* xb; float* opart;
    __device__ __forceinline__ void operator()(const f32x4 (&acc)[2][2][4][2], const Unit& u, int wr, int wc, int fr, int fq) const {
        const int row0 = u.pm * BM + wr * 64 + fr, col0 = u.pn * BM + wc * 32 + 8 * fq;
        u32x4 xws[2][4][2];
#pragma unroll
        for (int ai = 0; ai < 2; ++ai)
#pragma unroll
            for (int m = 0; m < 4; ++m)
#pragma unroll
                for (int bj = 0; bj < 2; ++bj) xws[ai][m][bj] = *(const u32x4*)(xb + (size_t)(row0 + ai * HALF + m * 16) * DM + col0 + bj * HALF);
#pragma unroll
        for (int ai = 0; ai < 2; ++ai)
#pragma unroll
            for (int m = 0; m < 4; ++m) {
                const int row = row0 + ai * HALF + m * 16; const size_t off = (size_t)row * DM + col0; float sq = 0.f;
#pragma unroll
                for (int bj = 0; bj < 2; ++bj) {
                    const u32x4 xw = xws[ai][m][bj];
                    const f32x4 o0 = (f32x4){bflo(xw.x), bfhi(xw.x), bflo(xw.y), bfhi(xw.y)} + acc[ai][bj][m][0];
                    const f32x4 o1 = (f32x4){bflo(xw.z), bfhi(xw.z), bflo(xw.w), bfhi(xw.w)} + acc[ai][bj][m][1];
                    if (OUT_F32) { __builtin_nontemporal_store(o0, (f32x4*)(xout + off + bj * HALF)); __builtin_nontemporal_store(o1, (f32x4*)(xout + off + bj * HALF + 4)); }
                    u32x4 w; w.x = cvtpk(o0[0], o0[1]); w.y = cvtpk(o0[2], o0[3]); w.z = cvtpk(o1[0], o1[1]); w.w = cvtpk(o1[2], o1[3]);
                    if (bj == 0) store16_wt<0>(xb + off, w); else store16_wt<HALF * 2>(xb + off, w);
                    sq += ((o0[0] * o0[0] + o0[1] * o0[1]) + (o0[2] * o0[2] + o0[3] * o0[3])) + ((o1[0] * o1[0] + o1[1] * o1[1]) + (o1[2] * o1[2] + o1[3] * o1[3]));
                }
                sq += __shfl_xor(sq, 16); sq += __shfl_xor(sq, 32);
                if (fq == 0 && opart) unsafeAtomicAdd(opart + row, sq);
            }
    }
};

template <int HOOK = 0, bool PUB = false, class Epi, class Sched, bool ALIGN_EPI = true>
__device__ __forceinline__ void gemm_phase(LAS unsigned char* lds, const Gemm g, const Sched& S, const Epi& E) {
    const int tid = tid_opaque(), wid = __builtin_amdgcn_readfirstlane(tid >> 6), lane = tid & 63, wr = wid >> 2, wc = wid & 3, fr = lane & 15, fq = lane >> 4;
    const int K = g.K, nt = K / BK, lda = g.lda, tj = g.tj; const long ajump = g.ajump;
#define PG8_AO(tt) ((long)(tt) * (long)kstep + ((tt) >= tj ? ajump : 0l))
    unsigned voffA[2], voffB[2];
#pragma unroll
    for (int i = 0; i < 2; ++i) { int R, C; stage_rc(tid * 16 + i * 8192, R, C); const int Rb = Epi::PERM ? ((R & ~31) + perm32(R & 31)) : R;
        voffA[i] = (unsigned)(R * lda + C) * 2u; voffB[i] = (unsigned)(Rb * K + C) * 2u; }
    const size_t kstep = (size_t)(BK * 2);
    const size_t hstepA = (size_t)HALF * lda * 2, hstepB = (size_t)HALF * K * 2;
    const size_t tstepA = 2 * hstepA, tstepB = 2 * hstepB;
    const unsigned ldsw = (unsigned)wid * 1024u;
    const int aoff = lds_byte(wr * 64 + fr, fq * 8), boff = lds_byte(wc * 32 + fr, fq * 8);
#define PG8_SA(b, h) (((b) * 2 + (h)) * HTB)
#define PG8_SB(b, h) ((4 + (b) * 2 + (h)) * HTB)
#define PG8_STAGE(bufoff, gbase, voff) do { _Pragma("unroll") for (int _i = 0; _i < 2; ++_i) \
        __builtin_amdgcn_global_load_lds((const unsigned*)((const char*)(gbase) + (voff)[_i]), (LAS unsigned*)(lds + (bufoff) + ldsw + _i * 8192), 16, 0, 0); } while (0)
#define PG8_LDA(dst, b, h) do { _Pragma("unroll") for (int m = 0; m < 4; ++m) _Pragma("unroll") for (int k = 0; k < 2; ++k) dst[m][k] = *(const LAS bf16x8*)(lds + PG8_SA(b, h) + aoff + m * 2048 + k * 1024); } while (0)
#define PG8_LDB(dst, b, h) do { _Pragma("unroll") for (int n = 0; n < 2; ++n) _Pragma("unroll") for (int k = 0; k < 2; ++k) dst[n][k] = *(const LAS bf16x8*)(lds + PG8_SB(b, h) + boff + n * 2048 + k * 1024); } while (0)
#define PG8_MMA(ai, bj, At, Bt) do { __builtin_amdgcn_s_setprio(1); _Pragma("unroll") for (int m = 0; m < 4; ++m) _Pragma("unroll") for (int n = 0; n < 2; ++n) _Pragma("unroll") for (int k = 0; k < 2; ++k) \
        acc[ai][bj][m][n] = __builtin_amdgcn_mfma_f32_16x16x32_bf16(Bt[n][k], At[m][k], acc[ai][bj][m][n], 0, 0, 0); __builtin_amdgcn_s_setprio(0); } while (0)
#define PG8_WAIT_V(n) asm volatile("s_waitcnt vmcnt(" #n ")" ::: "memory")
#define PG8_WAIT_L(n) asm volatile("s_waitcnt lgkmcnt(" #n ")" ::: "memory")
#define PG8_BAR __builtin_amdgcn_s_barrier()
#define PG8_SCHED __builtin_amdgcn_sched_barrier(0)
    Unit cur, nxt; int ui = 0; int prev_pm = 0; (void)prev_pm;
    if (!S.next(0, cur)) return;
    f32x4 acc[2][2][4][2];
#pragma unroll
    for (int a = 0; a < 2; ++a)
#pragma unroll
        for (int b = 0; b < 2; ++b)
#pragma unroll
            for (int m = 0; m < 4; ++m)
#pragma unroll
                for (int n = 0; n < 2; ++n) acc[a][b][m][n] = (f32x4){0.f, 0.f, 0.f, 0.f};
    bf16x8 At[4][2], B0[2][2], B1[2][2];
    const char* cA = (const char*)g.A + (size_t)cur.pm * tstepA; const char* cB = (const char*)g.Bt + (size_t)cur.pn * tstepB;
    PG8_STAGE(PG8_SB(0, 0), cB, voffB); PG8_STAGE(PG8_SB(0, 1), cB + hstepB, voffB); PG8_STAGE(PG8_SA(0, 0), cA, voffA); PG8_STAGE(PG8_SA(0, 1), cA + hstepA, voffA);
    if (wr == 1) PG8_BAR;
    PG8_WAIT_V(2); PG8_BAR;
    PG8_STAGE(PG8_SB(1, 0), cB + kstep, voffB); PG8_STAGE(PG8_SA(1, 0), cA + kstep, voffA); PG8_STAGE(PG8_SB(1, 1), cB + hstepB + kstep, voffB);
    PG8_WAIT_V(6); PG8_BAR;
    for (;;) {
        const bool has_next = S.next(ui + 1, nxt);
        const char* nA = has_next ? (const char*)g.A + (size_t)nxt.pm * tstepA : cA; const char* nB = has_next ? (const char*)g.Bt + (size_t)nxt.pn * tstepB : cB;
        for (int t = 0; t < nt; t += 2) {
            const bool last = (t == nt - 2);
            const char* a1 = cA + PG8_AO(t + 1);
            const char* a2 = last ? nA : cA + PG8_AO(t + 2); const char* b2 = last ? nB : cB + (size_t)(t + 2) * kstep;
            const char* a3 = last ? nA + kstep : cA + PG8_AO(t + 3); const char* b3 = b2 + kstep;
            if constexpr (HOOK != 0) {
                if (t == tj) {
                    int fro = fr; asm volatile("" : "+v"(fro));
#pragma unroll
                    for (int ai = 0; ai < 2; ++ai)
#pragma unroll
                        for (int m = 0; m < 4; ++m) {
                            float rs;
                            if constexpr (HOOK == 2) rs = ((const LAS float*)(lds + MISC_OFF + 1024))[ai * HALF + wr * 64 + m * 16 + fro];
                            else { const int row = cur.pm * BM + ai * HALF + wr * 64 + m * 16 + fro;
                                const f32x4 s0 = *(const f32x4*)(g.hpart + (size_t)row * 8), s1 = *(const f32x4*)(g.hpart + (size_t)row * 8 + 4);
                                rs = rsqrtf((((s0[0] + s0[1]) + (s0[2] + s0[3])) + ((s1[0] + s1[1]) + (s1[2] + s1[3]))) * (1.0f / 512.0f) + EPS); }
#pragma unroll
                            for (int bj = 0; bj < 2; ++bj)
#pragma unroll
                                for (int n = 0; n < 2; ++n) acc[ai][bj][m][n] = acc[ai][bj][m][n] * rs;
                        }
                }
            }
            PG8_LDB(B0, 0, 0); PG8_LDB(B1, 0, 1); PG8_SCHED; PG8_LDA(At, 0, 0); PG8_STAGE(PG8_SA(1, 1), a1 + hstepA, voffA);
            PG8_WAIT_V(8); PG8_WAIT_L(0); PG8_BAR; PG8_MMA(0, 0, At, B0); PG8_MMA(0, 1, At, B1); PG8_BAR; PG8_SCHED;
            PG8_LDA(At, 0, 1); PG8_STAGE(PG8_SB(0, 0), b2, voffB); PG8_STAGE(PG8_SB(0, 1), b2 + hstepB, voffB); PG8_STAGE(PG8_SA(0, 0), a2, voffA);
            PG8_WAIT_V(8); PG8_WAIT_L(0); PG8_BAR; PG8_MMA(1, 0, At, B0); PG8_MMA(1, 1, At, B1); PG8_BAR; PG8_SCHED;
            PG8_LDB(B0, 1, 0); PG8_LDB(B1, 1, 1); PG8_SCHED; PG8_LDA(At, 1, 0); PG8_STAGE(PG8_SA(0, 1), a2 + hstepA, voffA);
            PG8_WAIT_V(8); PG8_WAIT_L(0); PG8_BAR; PG8_MMA(0, 0, At, B0); PG8_MMA(0, 1, At, B1); PG8_BAR; PG8_SCHED;
            PG8_LDA(At, 1, 1); PG8_STAGE(PG8_SB(1, 0), b3, voffB); PG8_STAGE(PG8_SB(1, 1), b3 + hstepB, voffB); PG8_STAGE(PG8_SA(1, 0), a3, voffA);
            PG8_WAIT_V(8); PG8_WAIT_L(0); PG8_BAR; PG8_MMA(1, 0, At, B0); PG8_MMA(1, 1, At, B1); PG8_BAR; PG8_SCHED;
        }
        if constexpr (ALIGN_EPI) { if (wr == 0) PG8_BAR; }
        E(acc, cur, wr, wc, fr, fq);
        if (!has_next) break;
#pragma unroll
        for (int a = 0; a < 2; ++a)
#pragma unroll
            for (int b = 0; b < 2; ++b)
#pragma unroll
                for (int m = 0; m < 4; ++m)
#pragma unroll
                    for (int n = 0; n < 2; ++n) acc[a][b][m][n] = (f32x4){0.f, 0.f, 0.f, 0.f};
        cur = nxt; cA = nA; cB = nB; ++ui;
        if constexpr (ALIGN_EPI) { if (wr == 1) PG8_BAR; }
    }
    PG8_WAIT_V(0);
    if constexpr (PUB) {
        Unit up; for (int i = 0; S.next(i, up); ++i) if (lane == 0) __hip_atomic_fetch_add(g.pub + 64 * up.pm, 1, __ATOMIC_RELAXED, __HIP_MEMORY_SCOPE_AGENT);
    }
    if constexpr (!ALIGN_EPI) { if (wr == 0) PG8_BAR; }
    PG8_BAR;
#undef PG8_AO
#undef PG8_SA
#undef PG8_SB
#undef PG8_STAGE
#undef PG8_LDA
#undef PG8_LDB
#undef PG8_MMA
#undef PG8_WAIT_V
#undef PG8_WAIT_L
#undef PG8_BAR
#undef PG8_SCHED
}
}

__device__ __forceinline__ void transpose_item(const float* W, int K, int N, bf16* WT, const float* g, bool permq, LAS float* scr, int item, int lane, int gk0 = 0, int krot = 0) {
    const int nblk = N / 64, kb = item / nblk, nb = item % nblk, k0 = 32 * kb, n0 = 64 * nb;
    const int kr = lane >> 4, nc = (lane & 15) * 4;
    f32x4 v[8];
#pragma unroll
    for (int i = 0; i < 8; ++i) v[i] = __builtin_nontemporal_load((const f32x4*)(W + (size_t)(k0 + 4 * i + kr) * N + n0 + nc));
    if (g && k0 >= gk0) {
#pragma unroll
        for (int i = 0; i < 8; ++i) v[i] = v[i] * g[k0 - gk0 + 4 * i + kr];
    }
#pragma unroll
    for (int i = 0; i < 8; ++i) { LAS float* d = scr + (4 * i + kr) * 66 + nc; *(LAS f32x2*)d = (f32x2){v[i][0], v[i][1]}; *(LAS f32x2*)(d + 2) = (f32x2){v[i][2], v[i][3]}; }
    asm volatile("s_waitcnt lgkmcnt(0)" ::: "memory");
    const int c = lane >> 4;
#pragma unroll
    for (int j = 0; j < 4; ++j) { const int n = (lane & 15) + 16 * j; const LAS float* s = scr + (8 * c) * 66 + n;
        u32x4 o; o.x = cvtpk(s[0 * 66], s[1 * 66]); o.y = cvtpk(s[2 * 66], s[3 * 66]); o.z = cvtpk(s[4 * 66], s[5 * 66]); o.w = cvtpk(s[6 * 66], s[7 * 66]);
        int nn = n0 + n;
        if (permq && nn < 1024) { const int hd = nn >> 7, i = nn & 127; nn = hd * 128 + (i < 64 ? 2 * i : 2 * (i - 64) + 1); }
        *(u32x4*)(WT + (size_t)nn * K + ((k0 + krot) & (K - 1)) + 8 * c) = o; }
    asm volatile("s_waitcnt lgkmcnt(0)" ::: "memory");
}
__device__ __forceinline__ void rows2_to_bf16(const float* xrow, bf16* orow, float* prow, int lane) {
    const f32x4* xr = (const f32x4*)xrow + lane;
    f32x4 v[8]; float s0 = 0.f, s1 = 0.f;
#pragma unroll
    for (int j = 0; j < 8; ++j) v[j] = __builtin_nontemporal_load(xr + 64 * j);
#pragma unroll
    for (int j = 0; j < 4; ++j) { s0 += (v[j][0] * v[j][0] + v[j][1] * v[j][1]) + (v[j][2] * v[j][2] + v[j][3] * v[j][3]); s1 += (v[j + 4][0] * v[j + 4][0] + v[j + 4][1] * v[j + 4][1]) + (v[j + 4][2] * v[j + 4][2] + v[j + 4][3] * v[j + 4][3]); }
#pragma unroll
    for (int o = 1; o < 64; o <<= 1) { s0 += __shfl_xor(s0, o); s1 += __shfl_xor(s1, o); }
    u32x2* o8 = (u32x2*)orow + lane;
#pragma unroll
    for (int j = 0; j < 8; ++j) { u32x2 w; w.x = cvtpk(v[j][0], v[j][1]); w.y = cvtpk(v[j][2], v[j][3]); o8[64 * j] = w; }
    if (lane < 2) prow[lane] = (lane == 0) ? s0 : s1;
}

#define MFMA32(a, b, c) __builtin_amdgcn_mfma_f32_32x32x16_bf16((a), (b), (c), 0, 0, 0)
typedef short v4i16_t __attribute__((ext_vector_type(4)));
__device__ __forceinline__ s16x4 vtr(const LAS unsigned char* p) { return __builtin_bit_cast(s16x4, __builtin_amdgcn_ds_read_tr16_b64_v4i16((LAS v4i16_t*)p)); }
#define PACK8(x, s) ((u32x4){cvtpk((x)[8 * (s)], (x)[8 * (s) + 1]), cvtpk((x)[8 * (s) + 2], (x)[8 * (s) + 3]), cvtpk((x)[8 * (s) + 4], (x)[8 * (s) + 5]), cvtpk((x)[8 * (s) + 6], (x)[8 * (s) + 7])})

template <bool MASK>
__device__ __forceinline__ void sb_block(f32x16& X, int kb, int t, int hi, float& carry) {
    float e[16], m[16];
#pragma unroll
    for (int r = 0; r < 16; ++r) {
        e[r] = __builtin_amdgcn_exp2f(fminf(X[r], 80.0f));
        m[r] = __builtin_amdgcn_rcpf(1.0f + e[r]);
        if (MASK) { if (!(kb + crow(r, hi) < t)) { m[r] = 1.0f; e[r] = 0.f; } }
    }
    float b[4], ob[4];
#pragma unroll
    for (int g = 0; g < 4; ++g) { b[g] = (m[4 * g] * m[4 * g + 1]) * (m[4 * g + 2] * m[4 * g + 3]); ob[g] = __shfl_xor(b[g], 32); }
    float run = carry;
#pragma unroll
    for (int g = 3; g >= 0; --g) {
        const float suf = (hi == 0) ? run * ob[g] : run;
        const float c3 = m[4 * g + 3] * suf, c2 = m[4 * g + 2] * c3, c1 = m[4 * g + 1] * c2, c0 = m[4 * g] * c1;
        X[4 * g + 3] = e[4 * g + 3] * c3; X[4 * g + 2] = e[4 * g + 2] * c2; X[4 * g + 1] = e[4 * g + 1] * c1; X[4 * g] = e[4 * g] * c0;
        run *= b[g] * ob[g];
    }
    carry = run;
}
__device__ __forceinline__ void ret_block(f32x16& X, int kb, int t, int hi, float lg2) {
#pragma unroll
    for (int r = 0; r < 16; ++r) { const float d = fabsf((float)(t - (kb + crow(r, hi)))); X[r] *= __builtin_amdgcn_exp2f(lg2 * d); }
}
__device__ __forceinline__ void ret_block_f(f32x16& X, float f, float g1, float g8) {
    float fj = f;
#pragma unroll
    for (int j = 0; j < 4; ++j) { float fi = fj;
#pragma unroll
        for (int i = 0; i < 4; ++i) { X[4 * j + i] *= fi; fi *= g1; }
        fj *= g8; }
}

__device__ __forceinline__ void glds16(const void* gsrc, unsigned lds_dst) { unsigned keep;
    asm volatile("s_mov_b32 %0, m0\n\ts_mov_b32 m0, %2\n\ts_nop 0\n\tglobal_load_lds_dwordx4 %1, off\n\ts_mov_b32 m0, %0" : "=&s"(keep) : "v"(gsrc), "s"(lds_dst) : "memory"); }

template <int HD, bool SB>
__device__ __forceinline__ void attn_unit(LAS unsigned char* lds, bf16* P, int b, int h, int qb, float lg2, const float* gret, float* sbpart) {
    constexpr int PITCH = INC, NS = HD / 16, ND = HD / 32, RB = HD * 2, NC = HD / 8, NC64 = HD / 32, KBYTES = 64 * RB;
    const int tid = tid_opaque(), lane = tid & 63, w = __builtin_amdgcn_readfirstlane(tid >> 6), r32 = lane & 31, hi = lane >> 5;
    const int qcol = SB ? 2048 + h * 64 : h * 128, kcol = SB ? 2560 + h * 64 : 512 + h * 128, vcol = SB ? 3072 + h * 64 : 1024 + h * 128;
    const size_t rowbase = (size_t)b * SEQ;
    const int q0 = qb * 256, tq = q0 + 32 * w + r32, wlo = q0 + 32 * w;
    bf16x8 qf[NS];
    { const bf16* qp = P + (rowbase + tq) * PITCH + qcol + hi * 8;
#pragma unroll
      for (int s = 0; s < NS; ++s) qf[s] = *(const bf16x8*)(qp + 16 * s); }
#pragma unroll
    for (int s = 0; s < NS; ++s) asm volatile("" : "+v"(qf[s]));
    f32x16 o[ND];
#pragma unroll
    for (int d = 0; d < ND; ++d)
#pragma unroll
        for (int r = 0; r < 16; ++r) o[d][r] = 0.f;
    float carry = SB ? 1.0f : 0.f;
    float g1 = 1.f, g8 = 1.f, c32 = 1.f;
    if (!SB) { g1 = __builtin_amdgcn_exp2f(-lg2); g8 = __builtin_amdgcn_exp2f(-8.0f * lg2); c32 = __builtin_amdgcn_exp2f(-32.0f * lg2); }
    const int NT = 4 * (qb + 1);
    constexpr int TILEB = 2 * KBYTES, PIECES = TILEB / 1024, PPW = PIECES / 8, RPP = 1024 / RB;
    const int rip = lane / NC, pos = lane % NC;
    const unsigned lds0 = (unsigned)(uintptr_t)lds;
#define AT_DMA(kt, slot) do { _Pragma("unroll") for (int i_ = 0; i_ < PPW; ++i_) { const int pc_ = w * PPW + i_, mat_ = pc_ / (PIECES / 2), pim_ = pc_ % (PIECES / 2), row_ = pim_ * RPP + rip; \
        const int c_ = mat_ ? ((((pos >> 2) ^ (row_ & (NC64 - 1))) << 2) | (pos & 3)) : (pos ^ (row_ & (NC - 1))); \
        glds16(P + (rowbase + 64 * (kt) + row_) * PITCH + (mat_ ? vcol : kcol) + 8 * c_, (unsigned)__builtin_amdgcn_readfirstlane((int)(lds0 + (slot) * TILEB + mat_ * KBYTES + pim_ * 1024))); } } while (0)
    __syncthreads();
#define AT_TILE(j) (SB ? NT - 1 - (j) : (j))
    AT_DMA(AT_TILE(0), 0); AT_DMA(AT_TILE(1), 1); AT_DMA(AT_TILE(2), 2);
    int cur = 0;
    const int blk = (lane >> 4) & 1, p4 = lane & 3, q4 = (lane & 15) >> 2;
    volatile LAS int* flg = (volatile LAS int*)(lds + MISC_OFF + 64);
    bool wdone = false;
    for (int j = 0; j < NT; ++j, cur = (cur + 1) & 3) {
        const int kt = AT_TILE(j);
        if (j + 2 < NT) { if (PPW == 2) asm volatile("s_waitcnt vmcnt(4)" ::: "memory"); else asm volatile("s_waitcnt vmcnt(8)" ::: "memory"); }
        else if (j + 1 < NT) { if (PPW == 2) asm volatile("s_waitcnt vmcnt(2)" ::: "memory"); else asm volatile("s_waitcnt vmcnt(4)" ::: "memory"); }
        else asm volatile("s_waitcnt vmcnt(0)" ::: "memory");
        if (SB && lane == 0) flg[(kt & 1) * 8 + w] = wdone ? 1 : 0;
        __syncthreads();
        if (SB) { const LAS int* f4 = (const LAS int*)(lds + MISC_OFF + 64 + (kt & 1) * 32); const int a0 = f4[0] & f4[1] & f4[2] & f4[3] & f4[4] & f4[5] & f4[6] & f4[7]; if (a0) break; }
        if (j + 3 < NT) AT_DMA(AT_TILE(j + 3), (cur + 3) & 3);
        const bool part = SB ? (64 * kt < wlo + 31 && !wdone) : (kt <= (wlo >> 6));
        if (part) {
            const LAS unsigned char* Kb = lds + cur * TILEB; const LAS unsigned char* Vb = Kb + KBYTES;
            f32x16 p0, p1;
#pragma unroll
            for (int r = 0; r < 16; ++r) { p0[r] = 0.f; p1[r] = 0.f; }
#pragma unroll
            for (int sb = 0; sb < NS / 4; ++sb) {
                bf16x8 kf0[4], kf1[4];
#pragma unroll
                for (int i = 0; i < 4; ++i) { const int c = 2 * (4 * sb + i) + hi;
                    kf0[i] = *(const LAS bf16x8*)(Kb + r32 * RB + ((c ^ (r32 & (NC - 1))) << 4));
                    kf1[i] = *(const LAS bf16x8*)(Kb + (32 + r32) * RB + ((c ^ (r32 & (NC - 1))) << 4)); }
                __builtin_amdgcn_sched_barrier(0);
#pragma unroll
                for (int i = 0; i < 4; ++i) { p0 = MFMA32(kf0[i], qf[4 * sb + i], p0); p1 = MFMA32(kf1[i], qf[4 * sb + i], p1); }
                __builtin_amdgcn_sched_barrier(0);
            }
            s16x4 vl[ND][4], vh[ND][4];
            if (SB) {
#pragma unroll
                for (int d0 = 0; d0 < ND; ++d0)
#pragma unroll
                    for (int ks = 0; ks < 4; ++ks) { const int rowA = 16 * ks + 4 * hi + q4, rowB = rowA + 8;
                        vl[d0][ks] = vtr(Vb + rowA * RB + ((d0 ^ (rowA & (NC64 - 1))) << 6) + 32 * blk + 8 * p4);
                        vh[d0][ks] = vtr(Vb + rowB * RB + ((d0 ^ (rowB & (NC64 - 1))) << 6) + 32 * blk + 8 * p4); }
                __builtin_amdgcn_sched_barrier(0);
            }
            if (SB) {
                if (64 * kt + 63 < wlo) { sb_block<false>(p1, 64 * kt + 32, tq, hi, carry); sb_block<false>(p0, 64 * kt, tq, hi, carry); }
                else { sb_block<true>(p1, 64 * kt + 32, tq, hi, carry); sb_block<true>(p0, 64 * kt, tq, hi, carry); }
                wdone = __all(carry < 1e-37f) != 0;
            } else if (kt == (wlo >> 6)) { ret_block(p1, 64 * kt + 32, tq, hi, lg2); ret_block(p0, 64 * kt, tq, hi, lg2); }
            else { const float f0 = __builtin_amdgcn_exp2f(lg2 * (float)(tq - 64 * kt - 4 * hi)); ret_block_f(p0, f0, g1, g8); ret_block_f(p1, f0 * c32, g1, g8); }
            bf16x8 pa[4];
            pa[0] = __builtin_bit_cast(bf16x8, PACK8(p0, 0)); pa[1] = __builtin_bit_cast(bf16x8, PACK8(p0, 1));
            pa[2] = __builtin_bit_cast(bf16x8, PACK8(p1, 0)); pa[3] = __builtin_bit_cast(bf16x8, PACK8(p1, 1));
#pragma unroll
            for (int ks = 0; ks < 4; ++ks) {
                if (!SB) {
                    const int rowA = 16 * ks + 4 * hi + q4, rowB = rowA + 8;
#pragma unroll
                    for (int d0 = 0; d0 < ND; ++d0) {
                        vl[d0][ks] = vtr(Vb + rowA * RB + ((d0 ^ (rowA & (NC64 - 1))) << 6) + 32 * blk + 8 * p4);
                        vh[d0][ks] = vtr(Vb + rowB * RB + ((d0 ^ (rowB & (NC64 - 1))) << 6) + 32 * blk + 8 * p4); }
                    __builtin_amdgcn_sched_barrier(0);
                }
#pragma unroll
                for (int d0 = 0; d0 < ND; ++d0) {
                    const bf16x8 vf = __builtin_shufflevector(vl[d0][ks], vh[d0][ks], 0, 1, 2, 3, 4, 5, 6, 7);
                    o[d0] = MFMA32(vf, pa[ks], o[d0]);
                }
                if (!SB) __builtin_amdgcn_sched_barrier(0);
            }
        }
    }
#undef AT_DMA
#undef AT_TILE
    asm volatile("s_waitcnt vmcnt(0)" ::: "memory");
    bf16* orow = P + (rowbase + wlo + r32) * PITCH + qcol + 4 * hi;
    float ss = 0.f;
#pragma unroll
    for (int d0 = 0; d0 < ND; ++d0)
#pragma unroll
        for (int r = 0; r < 16; ++r) ss += o[d0][r] * o[d0][r];
    ss += __shfl_xor(ss, 32);
    if (SB) {
        if (hi == 0) sbpart[(rowbase + wlo + r32) * 8 + h] = ss;
#pragma unroll
        for (int d0 = 0; d0 < ND; ++d0)
#pragma unroll
            for (int g = 0; g < 4; ++g) { u32x2 wv; wv.x = cvtpk(o[d0][4 * g], o[d0][4 * g + 1]); wv.y = cvtpk(o[d0][4 * g + 2], o[d0][4 * g + 3]); *(u32x2*)(orow + 32 * d0 + 8 * g) = wv; }
    } else {
        const float rs = rsqrtf(ss * (1.0f / 128.0f) + EPS);
        u32x2 gt[ND][4]; f32x4 gr[ND][4];
#pragma unroll
        for (int d0 = 0; d0 < ND; ++d0)
#pragma unroll
            for (int g = 0; g < 4; ++g) { gt[d0][g] = *(const u32x2*)(orow + 1536 + 32 * d0 + 8 * g); gr[d0][g] = *(const f32x4*)(gret + h * 128 + 32 * d0 + 8 * g + 4 * hi); }
#pragma unroll
        for (int d0 = 0; d0 < ND; ++d0)
#pragma unroll
            for (int g = 0; g < 4; ++g) {
                const f32x4 gg = gr[d0][g] * rs; u32x2 wv;
                wv.x = cvtpk(o[d0][4 * g] * gg[0] * bflo(gt[d0][g].x), o[d0][4 * g + 1] * gg[1] * bfhi(gt[d0][g].x));
                wv.y = cvtpk(o[d0][4 * g + 2] * gg[2] * bflo(gt[d0][g].y), o[d0][4 * g + 3] * gg[3] * bfhi(gt[d0][g].y));
                *(u32x2*)(orow + 32 * d0 + 8 * g) = wv;
            }
    }
}

__device__ __forceinline__ void sb_unit(LAS unsigned char* lds, bf16* P, int b, int h, int qb, float* sbpart) {
    constexpr int PITCH = INC, NS = 4, ND = 2, RB = 128;
    const int tid = tid_opaque(), lane = tid & 63, w = __builtin_amdgcn_readfirstlane(tid >> 6), r32 = lane & 31, hi = lane >> 5;
    const int qcol = 2048 + h * 64, kcol = 2560 + h * 64, vcol = 3072 + h * 64;
    const size_t rowbase = (size_t)b * SEQ;
    const int q0 = qb * 256, wlo = q0 + 32 * w, tq = wlo + r32;
    bf16x8 qf[NS];
    { const bf16* qp = P + (rowbase + tq) * PITCH + qcol + hi * 8;
#pragma unroll
      for (int s = 0; s < NS; ++s) qf[s] = *(const bf16x8*)(qp + 16 * s); }
#pragma unroll
    for (int s = 0; s < NS; ++s) asm volatile("" : "+v"(qf[s]));
    f32x16 o[ND];
#pragma unroll
    for (int d = 0; d < ND; ++d)
#pragma unroll
        for (int r = 0; r < 16; ++r) o[d][r] = 0.f;
    float carry = 1.0f;
    const unsigned wbase = (unsigned)(uintptr_t)lds + (unsigned)w * 16384u;
    const LAS unsigned char* wl = lds + w * 16384;
    const int rip = lane >> 3, pos = lane & 7;
#define SB_DMA(hb, slot) do { _Pragma("unroll") for (int pc_ = 0; pc_ < 8; ++pc_) { const int mat_ = pc_ >> 2, row_ = 8 * (pc_ & 3) + rip; \
        const int c_ = mat_ ? ((((pos >> 2) ^ (row_ & 1)) << 2) | (pos & 3)) : (pos ^ (row_ & 7)); \
        glds16(P + (rowbase + 32 * (hb) + row_) * PITCH + (mat_ ? vcol : kcol) + 8 * c_, (unsigned)__builtin_amdgcn_readfirstlane((int)(wbase + (slot) * 8192 + mat_ * 4096 + (pc_ & 3) * 1024))); } } while (0)
    const int hb0 = wlo >> 5;
    __syncthreads();
    SB_DMA(hb0, 0);
    const int blk = (lane >> 4) & 1, p4 = lane & 3, q4 = (lane & 15) >> 2;
    int sl = 0;
    for (int hb = hb0; hb >= 0; --hb, sl ^= 1) {
        if (hb > 0) { SB_DMA(hb - 1, sl ^ 1); asm volatile("s_waitcnt vmcnt(8)" ::: "memory"); }
        else asm volatile("s_waitcnt vmcnt(0)" ::: "memory");
        const LAS unsigned char* Kb = wl + sl * 8192; const LAS unsigned char* Vb = Kb + 4096;
        f32x16 p;
#pragma unroll
        for (int r = 0; r < 16; ++r) p[r] = 0.f;
        bf16x8 kf[NS];
#pragma unroll
        for (int s = 0; s < NS; ++s) kf[s] = *(const LAS bf16x8*)(Kb + r32 * RB + (((2 * s + hi) ^ (r32 & 7)) << 4));
        s16x4 vl[ND][2], vh[ND][2];
#pragma unroll
        for (int d0 = 0; d0 < ND; ++d0)
#pragma unroll
            for (int ks = 0; ks < 2; ++ks) { const int rowA = 16 * ks + 4 * hi + q4, rowB = rowA + 8;
                vl[d0][ks] = vtr(Vb + rowA * RB + ((d0 ^ (rowA & 1)) << 6) + 32 * blk + 8 * p4);
                vh[d0][ks] = vtr(Vb + rowB * RB + ((d0 ^ (rowB & 1)) << 6) + 32 * blk + 8 * p4); }
#pragma unroll
        for (int s = 0; s < NS; ++s) p = MFMA32(kf[s], qf[s], p);
        if (32 * hb + 31 < wlo) sb_block<false>(p, 32 * hb, tq, hi, carry); else sb_block<true>(p, 32 * hb, tq, hi, carry);
        bf16x8 pa[2];
        pa[0] = __builtin_bit_cast(bf16x8, PACK8(p, 0)); pa[1] = __builtin_bit_cast(bf16x8, PACK8(p, 1));
#pragma unroll
        for (int ks = 0; ks < 2; ++ks)
#pragma unroll
            for (int d0 = 0; d0 < ND; ++d0) {
                const bf16x8 vf = __builtin_shufflevector(vl[d0][ks], vh[d0][ks], 0, 1, 2, 3, 4, 5, 6, 7);
                o[d0] = MFMA32(vf, pa[ks], o[d0]);
            }
        if (__all(carry < 1e-37f)) break;
    }
#undef SB_DMA
    asm volatile("s_waitcnt vmcnt(0)" ::: "memory");
    bf16* orow = P + (rowbase + wlo + r32) * PITCH + qcol + 4 * hi;
    float ss = 0.f;
#pragma unroll
    for (int d0 = 0; d0 < ND; ++d0)
#pragma unroll
        for (int r = 0; r < 16; ++r) ss += o[d0][r] * o[d0][r];
    ss += __shfl_xor(ss, 32);
    if (hi == 0) sbpart[(rowbase + wlo + r32) * 8 + h] = ss;
#pragma unroll
    for (int d0 = 0; d0 < ND; ++d0)
#pragma unroll
        for (int g = 0; g < 4; ++g) { u32x2 wv; wv.x = cvtpk(o[d0][4 * g], o[d0][4 * g + 1]); wv.y = cvtpk(o[d0][4 * g + 2], o[d0][4 * g + 3]); *(u32x2*)(orow + 32 * d0 + 8 * g) = wv; }
}

__device__ __forceinline__ void xattn_unit(LAS unsigned char* lds, const bf16* Q, const bf16* KV, const float* qpart, bf16* O, int b, int h, int tb) {
    const int tid = tid_opaque(), lane = tid & 63, w = __builtin_amdgcn_readfirstlane(tid >> 6), r32 = lane & 31, hi = lane >> 5;
    const size_t Rw = (size_t)b * SEQ + tb * 256 + 32 * w, R = Rw + r32;
    const bf16* kvb = KV + (size_t)b * NMEM * 2048 + h * 256;
    const unsigned ldsb = (unsigned)(uintptr_t)lds; const int rip = lane >> 5, pos = lane & 31;
    __syncthreads();
#pragma unroll
    for (int i = 0; i < 16; ++i) { const int pim = w * 16 + i, row = 2 * pim + rip, c = pos ^ (row & 31);
        glds16(kvb + (size_t)row * 2048 + c * 8, (unsigned)__builtin_amdgcn_readfirstlane((int)(ldsb + pim * 1024))); }
    asm volatile("s_waitcnt vmcnt(0)" ::: "memory");
    __syncthreads();
    const bf16* qp = Q + R * DM + h * 256 + hi * 8;
    const f32x4 qq = *(const f32x4*)(qpart + R * 16 + h * 4);
    const float rq = rsqrtf(((qq[0] + qq[1]) + (qq[2] + qq[3])) * (1.0f / 256.0f) + EPS);
    float l = 0.f; bf16x8 pa[8][2];
#pragma unroll
    for (int half = 0; half < 2; ++half) {
        f32x16 p[4];
#pragma unroll
        for (int kb = 0; kb < 4; ++kb)
#pragma unroll
            for (int r = 0; r < 16; ++r) p[kb][r] = 0.f;
#pragma unroll
        for (int s = 0; s < 16; ++s) {
            const bf16x8 qf = *(const bf16x8*)(qp + 16 * s); const int c = 2 * s + hi;
#pragma unroll
            for (int kb = 0; kb < 4; ++kb) { const bf16x8 kf = *(const LAS bf16x8*)(lds + (128 * half + 32 * kb + r32) * 512 + ((c ^ r32) << 4)); p[kb] = MFMA32(kf, qf, p[kb]); }
        }
        if (half == 1) {
            asm volatile("s_waitcnt lgkmcnt(0)" ::: "memory");
            __syncthreads();
#pragma unroll
            for (int i = 0; i < 16; ++i) { const int pim = w * 16 + i, row = 2 * pim + rip, c = (((pos >> 2) ^ (row & 7)) << 2) | (pos & 3);
                glds16(kvb + 1024 + (size_t)row * 2048 + c * 8, (unsigned)__builtin_amdgcn_readfirstlane((int)(ldsb + pim * 1024))); __builtin_amdgcn_sched_barrier(0); }
        }
#pragma unroll
        for (int kb = 0; kb < 4; ++kb) {
#pragma unroll
            for (int r = 0; r < 16; ++r) { const float e = __builtin_amdgcn_exp2f(p[kb][r] * rq); l += e; p[kb][r] = e; }
            pa[4 * half + kb][0] = __builtin_bit_cast(bf16x8, PACK8(p[kb], 0)); pa[4 * half + kb][1] = __builtin_bit_cast(bf16x8, PACK8(p[kb], 1));
        }
    }
    l += __shfl_xor(l, 32);
    const float rl = 1.0f / l;
    asm volatile("s_waitcnt vmcnt(0)" ::: "memory");
    __syncthreads();
    const int blk = (lane >> 4) & 1, p4 = lane & 3, q4 = (lane & 15) >> 2;
    bf16* op = O + R * DM + h * 256 + 4 * hi;
#pragma unroll
    for (int dp = 0; dp < 4; ++dp) {
        f32x16 oa[2], ob[2];
#pragma unroll
        for (int e = 0; e < 2; ++e)
#pragma unroll
            for (int r = 0; r < 16; ++r) { oa[e][r] = 0.f; ob[e][r] = 0.f; }
#pragma unroll
        for (int ks = 0; ks < 16; ks += 2) {
            s16x4 lo[2][2], hh[2][2];
#pragma unroll
            for (int kk = 0; kk < 2; ++kk) { const int rowA = 16 * (ks + kk) + 4 * hi + q4, rowB = rowA + 8;
#pragma unroll
                for (int e = 0; e < 2; ++e) { const int d0 = 2 * dp + e;
                    lo[kk][e] = vtr(lds + rowA * 512 + ((d0 ^ (rowA & 7)) << 6) + 32 * blk + 8 * p4);
                    hh[kk][e] = vtr(lds + rowB * 512 + ((d0 ^ (rowB & 7)) << 6) + 32 * blk + 8 * p4); } }
#pragma unroll
            for (int e = 0; e < 2; ++e) {
                oa[e] = MFMA32(__builtin_shufflevector(lo[0][e], hh[0][e], 0, 1, 2, 3, 4, 5, 6, 7), pa[ks >> 1][0], oa[e]);
                ob[e] = MFMA32(__builtin_shufflevector(lo[1][e], hh[1][e], 0, 1, 2, 3, 4, 5, 6, 7), pa[ks >> 1][1], ob[e]);
            }
        }
#pragma unroll
        for (int e = 0; e < 2; ++e)
#pragma unroll
            for (int g = 0; g < 4; ++g) {
                u32x2 wv; wv.x = cvtpk((oa[e][4 * g] + ob[e][4 * g]) * rl, (oa[e][4 * g + 1] + ob[e][4 * g + 1]) * rl); wv.y = cvtpk((oa[e][4 * g + 2] + ob[e][4 * g + 2]) * rl, (oa[e][4 * g + 3] + ob[e][4 * g + 3]) * rl);
                *(u32x2*)(op + 32 * (2 * dp + e) + 8 * g) = wv; }
    }
}

#define XB_TMO      128
#define XB_XCNT(j)  (256  + 64 * (j))
#define XB_XSUB(j)  (1280 + 64 * (j))
#define XB_XGEN(j)  (2304 + 64 * (j))
#define XB_TOP      3328
#define XB_TOPGEN   3392
#define XCD_BAR_WORDS 3456
#define XB_SPIN_CAP (1u << 18)

__device__ __forceinline__ unsigned xb_ld(unsigned* p)              { return __hip_atomic_load(p, __ATOMIC_RELAXED, __HIP_MEMORY_SCOPE_AGENT); }
__device__ __forceinline__ unsigned xb_add(unsigned* p, unsigned v) { return __hip_atomic_fetch_add(p, v, __ATOMIC_RELAXED, __HIP_MEMORY_SCOPE_AGENT); }
__device__ __forceinline__ unsigned xb_xcc_id() { return (unsigned)__builtin_amdgcn_s_getreg((3 << 11) | 20) & 0xFu; }
#define XB_SPIN(cond, bar) do { unsigned _sp = 0; while (cond) { __builtin_amdgcn_s_sleep(1); \
    if ((++_sp & 255u) == 0u) { if (xb_ld(&(bar)[XB_TMO])) break; if (_sp > XB_SPIN_CAP) { atomicAdd(&(bar)[XB_TMO], 1u); break; } } } } while (0)

struct XcdBarrier {
    unsigned* bar; unsigned x;
    volatile LAS unsigned* st;
};

__device__ __forceinline__ XcdBarrier xcd_barrier_post(unsigned* bar, volatile LAS unsigned* st) {
    XcdBarrier b; b.bar = bar; b.x = xb_xcc_id(); b.st = st;
    if (threadIdx.x == 0) (void)xb_add(&bar[XB_XCNT(b.x)], 1u);
    return b;
}
__device__ __forceinline__ void xcd_barrier_complete(unsigned* bar, unsigned x, unsigned& nloc, unsigned& nx) {
    const unsigned G = gridDim.x * gridDim.y * gridDim.z;
    unsigned sum, cnt, mine, sp = 0u;
    for (;;) {
        sum = 0u; cnt = 0u; mine = 0u;
#pragma unroll
        for (unsigned j = 0; j < 16; ++j) { const unsigned c = xb_ld(&bar[XB_XCNT(j)]); sum += c; cnt += (c > 0u) ? 1u : 0u; mine = (j == x) ? c : mine; }
        if (sum == G) break;
        __builtin_amdgcn_s_sleep(1);
        if ((++sp & 255u) == 0u) { if (xb_ld(&bar[XB_TMO])) break; if (sp > XB_SPIN_CAP) { atomicAdd(&bar[XB_TMO], 1u); break; } }
    }
    nloc = mine > 0u ? mine : 1u; nx = cnt > 0u ? cnt : 1u;
}

__device__ __forceinline__ void xcd_barrier(const XcdBarrier& b) {
    asm volatile("s_waitcnt vmcnt(0)" ::: "memory");
    __syncthreads();
    if (threadIdx.x == 0) {
        unsigned* bar = b.bar;
        __builtin_amdgcn_s_waitcnt(0);
        unsigned nloc = b.st[0], nx = b.st[1];
        if (nloc == 0u) { xcd_barrier_complete(bar, b.x, nloc, nx); b.st[0] = nloc; b.st[1] = nx; }
        const unsigned old = xb_add(&bar[XB_XSUB(b.x)], 1u);
        const unsigned gen = old / nloc;
        if (old + 1u == (gen + 1u) * nloc) {
            __builtin_amdgcn_fence(__ATOMIC_RELEASE, "agent");
            asm volatile("s_waitcnt vmcnt(0)" ::: "memory");
            const unsigned og = xb_add(&bar[XB_TOP], 1u);
            const unsigned tg = og / nx;
            if (og + 1u == (tg + 1u) * nx) xb_add(&bar[XB_TOPGEN], 1u);
            else XB_SPIN(xb_ld(&bar[XB_TOPGEN]) == tg, bar);
            __builtin_amdgcn_fence(__ATOMIC_ACQUIRE, "agent");
            xb_add(&bar[XB_XGEN(b.x)], 1u);
            asm volatile("s_waitcnt vmcnt(0)" ::: "memory");
        } else {
            XB_SPIN(xb_ld(&bar[XB_XGEN(b.x)]) == gen, bar);
            __builtin_amdgcn_fence(__ATOMIC_ACQUIRE, "agent");
            asm volatile("s_waitcnt vmcnt(0)" ::: "memory");
        }
    }
    __syncthreads();
}

struct Args { const float* in[17]; float* out; unsigned char* ws; };
typedef const __attribute__((address_space(4))) Args* cargs_t;
__device__ __forceinline__ cargs_t get_args() { cargs_t p = (cargs_t)__builtin_amdgcn_kernarg_segment_ptr(); asm volatile("" : "+s"(p)); return p; }
#define PHASE_VARS cargs_t A = get_args(); unsigned char* ws = A->ws; const int tid = tid_opaque(), lane = tid & 63, wave = __builtin_amdgcn_readfirstlane(tid >> 6), G = gridDim.x, bx = blockIdx.x, gw = bx * 8 + wave, NGW = G * 8; (void)lane; (void)gw; (void)NGW; (void)ws
#define P_XB ((bf16*)(ws + WS_XB))
#define P_R1 ((bf16*)(ws + WS_R1))
#define P_O ((bf16*)(ws + WS_O))
#define P_KV ((bf16*)(ws + WS_KV))
#define P_MEMB ((bf16*)(ws + WS_MEMB))
#define P_XSS(slot) ((float*)(ws + WS_XSS) + (size_t)(slot) * T_TOK)
#define P_QPART ((float*)(ws + WS_QPART))
#define P_KPART ((float*)(ws + WS_KPART))
#define P_MSS ((float*)(ws + WS_MSS))
#define P_CTR ((int*)(ws + WS_CTR))
#define P_WL(l) ((const bf16*)(ws + WS_W + (size_t)(l) * W_LAYER))

__global__ void __launch_bounds__(512, 2) hymba_fwd(Args a_unused) {
    extern __shared__ __attribute__((aligned(16))) unsigned char lds_raw[];
    LAS unsigned char* lds = (LAS unsigned char*)lds_raw;
    cg::grid_group grid = cg::this_grid();
    if (threadIdx.x < 8) ((volatile LAS unsigned*)(lds + MISC_OFF + 128))[threadIdx.x] = 0u;
    __syncthreads();
    { cargs_t A0 = get_args(); (void)xcd_barrier_post((unsigned*)(A0->ws + WS_BAR), (volatile LAS unsigned*)(lds + MISC_OFF + 128)); }
    if (gridDim.x == 0x7fffffffu) grid.sync();
#define GRID_SYNC() do { XcdBarrier b_; b_.bar = (unsigned*)(get_args()->ws + WS_BAR); b_.x = xb_xcc_id(); b_.st = (volatile LAS unsigned*)(lds + MISC_OFF + 128); xcd_barrier(b_); } while (0)

    {
        PHASE_VARS;
        LAS float* scr = (LAS float*)(lds + wave * 16384);
        constexpr int I_IN = 32 * (INC / 64), I_SQ = 32 * 16, I_KV = 32 * 32, I_UP = 32 * 64, I_DN = 128 * 16;
        constexpr int PER_LAYER = I_IN + 3 * I_SQ + I_KV + I_UP + I_DN;
        for (int it = gw; it < 2 * PER_LAYER; it += NGW) {
            const int itr = 2 * PER_LAYER - 1 - it;
            const int l = itr / PER_LAYER; int r = itr % PER_LAYER;
            bf16* wl = (bf16*)(ws + WS_W + (size_t)l * W_LAYER);
            if (r < I_IN) { transpose_item(A->in[3] + (size_t)l * DM * INC, DM, INC, wl + WO_IN / 2, A->in[2] + l * DM, true, scr, r, lane); continue; } r -= I_IN;
            if (r < I_SQ) { transpose_item(A->in[6] + (size_t)l * DM * DM, DM, DM, wl + WO_MIX / 2, A->in[5] + l * 512, false, scr, r, lane, 512, 512); continue; } r -= I_SQ;
            if (r < I_SQ) { transpose_item(A->in[9] + (size_t)l * DM * DM, DM, DM, wl + WO_XQ / 2, A->in[7] + l * DM, false, scr, r, lane); continue; } r -= I_SQ;
            if (r < I_KV) { transpose_item(A->in[10] + (size_t)l * DM * 2048, DM, 2048, wl + WO_XKV / 2, A->in[8] + l * DM, false, scr, r, lane); continue; } r -= I_KV;
            if (r < I_SQ) { transpose_item(A->in[13] + (size_t)l * DM * DM, DM, DM, wl + WO_XO / 2, nullptr, false, scr, r, lane); continue; } r -= I_SQ;
            if (r < I_UP) { transpose_item(A->in[15] + (size_t)l * DM * FF, DM, FF, wl + WO_UP / 2, A->in[14] + l * DM, false, scr, r, lane); continue; } r -= I_UP;
            transpose_item(A->in[16] + (size_t)l * FF * DM, FF, DM, wl + WO_DOWN / 2, nullptr, false, scr, r, lane);
        }
        const float* x_in = A->in[0]; const float* mem = A->in[1];
        for (int m = 2 * gw; m < T_TOK; m += 2 * NGW) rows2_to_bf16(x_in + (size_t)m * DM, P_XB + (size_t)m * DM, P_XSS(0) + m, lane);
        for (int m = 2 * gw; m < MROWS; m += 2 * NGW) rows2_to_bf16(mem + (size_t)m * DM, P_MEMB + (size_t)m * DM, P_MSS + m, lane);
        if (bx == 0 && tid < 16) P_CTR[tid] = 0;
    }
    GRID_SYNC();

    for (int l = 0; l < 2; ++l) {
        asm volatile("" : "+s"(l));
        {
            PHASE_VARS;
            pg8::Gemm g{P_XB, P_WL(l) + WO_IN / 2, T_TOK, INC, DM, DM, 1 << 30, 0l, nullptr}; pg8::StaticOrder S; S.init(T_TOK, INC, G, bx);
            pg8::EpiB<pg8::EM_PROJ> E{P_R1, INC, P_XSS(3 * l), nullptr};
            pg8::gemm_phase(lds, g, S, E);
        }
        {
            PHASE_VARS;
            pg8::Gemm g2{P_MEMB, P_WL(l) + WO_XKV / 2, MROWS, 2048, DM, DM, 1 << 30, 0l, nullptr}; pg8::StaticOrder S2; S2.init(MROWS, 2048, G, G - 1 - bx);
            pg8::EpiB<pg8::EM_KV> E2{P_KV, 2048, P_MSS, P_KPART};
            pg8::gemm_phase(lds, g2, S2, E2);
        }
        GRID_SYNC();
        {
            PHASE_VARS;
            const float* gqn = A->in[11] + l * 256; const float* gkn = A->in[12] + l * 256;
            bf16* kv = P_KV; const float* kpart = P_KPART;
            for (int it = gw; it < MROWS * 4; it += NGW) {
                const int row = it >> 2, hh = it & 3;
                const f32x4 kp = *(const f32x4*)(kpart + (size_t)row * 16 + hh * 4);
                const float rk = rsqrtf(((kp[0] + kp[1]) + (kp[2] + kp[3])) * (1.0f / 256.0f) + EPS) * (0.0625f * 1.4426950408889634f);
                u32x2* p = (u32x2*)(kv + (size_t)row * 2048 + hh * 256) + lane;
                const u32x2 v = *p; const f32x4 g1 = *((const f32x4*)gqn + lane), g2 = *((const f32x4*)gkn + lane);
                u32x2 o; o.x = cvtpk(bflo(v.x) * rk * g1[0] * g2[0], bfhi(v.x) * rk * g1[1] * g2[1]); o.y = cvtpk(bflo(v.y) * rk * g1[2] * g2[2], bfhi(v.y) * rk * g1[3] * g2[3]);
                *p = o;
            }
        }
        {
            PHASE_VARS;
            volatile LAS int* misc = (volatile LAS int*)(lds + MISC_OFF);
            const float* gret = A->in[4] + l * 512;
            for (int u = bx; u < 256; u += G) { const int bb = u & 7, idx = u >> 3, hh = idx >> 3, qb = idx & 7; attn_unit<128, false>(lds, P_R1, bb, hh, qb, log2f(1.0f - exp2f(-5.0f - (float)hh)), gret, nullptr); }
            for (;;) {
                if (tid == 0) misc[0] = atomicAdd(P_CTR + l, 1);
                __syncthreads();
                const int u = misc[0];
                __syncthreads();
                if (u >= 512) break;
                const int qb = 7 - (u >> 6), j = u & 63; sb_unit(lds, P_R1, j >> 3, j & 7, qb, P_QPART);
            }
        }
        GRID_SYNC();
        {
            PHASE_VARS;
            pg8::Gemm g{P_R1 + 2048, P_WL(l) + WO_MIX / 2, T_TOK, DM, DM, INC, 8, -5120l, P_QPART}; pg8::StaticOrder S; S.init(T_TOK, DM, G, bx);
            pg8::EpiRes<false> E{nullptr, P_XB, P_XSS(3 * l + 1)};
            if (G >= 256) {
                pg8::Unit u0;
                if (S.next(0, u0) && tid < 256) { const float* hp = P_QPART + (size_t)(u0.pm * 256 + tid) * 8; const f32x4 s0 = *(const f32x4*)hp, s1 = *(const f32x4*)(hp + 4);
                    ((LAS float*)(lds + MISC_OFF + 1024))[tid] = rsqrtf((((s0[0] + s0[1]) + (s0[2] + s0[3])) + ((s1[0] + s1[1]) + (s1[2] + s1[3]))) * (1.0f / 512.0f) + EPS); }
                __syncthreads();
                pg8::gemm_phase<2>(lds, g, S, E);
            } else pg8::gemm_phase<1>(lds, g, S, E);
        }
        GRID_SYNC();
        {
            PHASE_VARS;
            pg8::Gemm g{P_XB, P_WL(l) + WO_XQ / 2, T_TOK, DM, DM, DM, 1 << 30, 0l, nullptr}; pg8::StaticOrder S; S.init(T_TOK, DM, G, bx);
            pg8::EpiB<pg8::EM_Q> E{P_R1, DM, P_XSS(3 * l + 1), P_QPART};
            pg8::gemm_phase(lds, g, S, E);
        }
        {
            PHASE_VARS;
            __syncthreads();
            pg8::StaticOrder S; S.init(T_TOK, DM, G, bx); pg8::Unit u;
            for (int i = 0; S.next(i, u); ++i) xattn_unit(lds, P_R1, P_KV, P_QPART, P_O, u.pm >> 3, u.pn, u.pm & 7);
        }
        GRID_SYNC();
        {
            PHASE_VARS;
            pg8::Gemm g{P_O, P_WL(l) + WO_XO / 2, T_TOK, DM, DM, DM, 1 << 30, 0l, nullptr}; pg8::StaticOrder S; S.init(T_TOK, DM, G, bx);
            pg8::EpiRes<false> E{nullptr, P_XB, P_XSS(3 * l + 2)};
            pg8::gemm_phase(lds, g, S, E);
        }
        GRID_SYNC();
        {
            PHASE_VARS;
            pg8::Gemm g{P_XB, P_WL(l) + WO_UP / 2, T_TOK, FF, DM, DM, 1 << 30, 0l, nullptr}; pg8::StaticOrder S; S.init(T_TOK, FF, G, bx);
            g.pub = (int*)(ws + WS_PUB) + l * 4096;
            pg8::EpiB<pg8::EM_UP> E{P_R1, FF, P_XSS(3 * l + 2), nullptr};
            pg8::gemm_phase<false, true>(lds, g, S, E);
        }
        {
            PHASE_VARS;
            {
                pg8::StaticOrder Sw; Sw.init(T_TOK, DM, G, bx); pg8::Unit uw;
                if (wave == 0) {
                    int* pub = (int*)(ws + WS_PUB) + l * 4096;
                    for (int i = 0; Sw.next(i, uw); ++i) {
                        unsigned spins = 0;
                        while (__builtin_amdgcn_readfirstlane(__hip_atomic_load(pub + 64 * uw.pm, __ATOMIC_RELAXED, __HIP_MEMORY_SCOPE_AGENT)) < 128) { __builtin_amdgcn_s_sleep(2); if (++spins > (1u << 22)) break; }
                    }
                    __builtin_amdgcn_fence(__ATOMIC_ACQUIRE, "agent");
                    asm volatile("s_waitcnt vmcnt(0)" ::: "memory");
                }
                __syncthreads();
            }
            pg8::Gemm g{P_R1, P_WL(l) + WO_DOWN / 2, T_TOK, DM, FF, FF, 1 << 30, 0l, nullptr}; pg8::StaticOrder S; S.init(T_TOK, DM, G, bx);
            if (l == 1) { pg8::EpiRes<true> E{A->out, P_XB, nullptr}; pg8::gemm_phase(lds, g, S, E); }
            else { pg8::EpiRes<false> E{nullptr, P_XB, P_XSS(3 * l + 3)}; pg8::gemm_phase(lds, g, S, E); }
        }
        if (l == 0) GRID_SYNC();
    }
}

extern "C" void kernel_launch(void* const* d_in, const int* in_sizes, int n_in, void* d_out, int out_size, void* d_ws, size_t ws_size, hipStream_t stream) {
    static int grid = 0;
    if (grid == 0) {
        if (n_in != 17 || ws_size < WS_END) { fprintf(stderr, "kernel_launch: unexpected n_in %d / ws_size %zu\n", n_in, ws_size); grid = -1; return; }
        int dev = 0, cus = 0, per_cu = 0;
        hipGetDevice(&dev);
        hipDeviceGetAttribute(&cus, hipDeviceAttributeMultiprocessorCount, dev);
        hipFuncSetAttribute((const void*)hymba_fwd, hipFuncAttributeMaxDynamicSharedMemorySize, LDS_BYTES);
        hipOccupancyMaxActiveBlocksPerMultiprocessor(&per_cu, (const void*)hymba_fwd, 512, LDS_BYTES);
        if (per_cu < 1) { fprintf(stderr, "kernel_launch: occupancy query reports %d blocks per CU\n", per_cu); per_cu = 1; }
        grid = cus;
    }
    if (grid < 0) return;
    if (hipMemsetAsync((char*)d_ws + WS_CTR, 0, WS_CTL_BYTES, stream) != hipSuccess) { fprintf(stderr, "kernel_launch: memset of control words failed\n"); return; }
    Args a{};
    for (int i = 0; i < 17; ++i) a.in[i] = (const float*)d_in[i];
    a.out = (float*)d_out; a.ws = (unsigned char*)d_ws;
    void* args[] = {&a};
    hipError_t e = hipLaunchCooperativeKernel((const void*)hymba_fwd, dim3(grid), dim3(512), args, LDS_BYTES, stream);
    if (e != hipSuccess) fprintf(stderr, "cooperative launch failed: %s (grid %d)\n", hipGetErrorString(e), grid);
}
```

```cpp
#include <hip/hip_runtime.h>
#include <hip/hip_cooperative_groups.h>
#include <cstdio>
#include <cstdint>
namespace cg = cooperative_groups;

#define LAS __attribute__((address_space(3)))
typedef unsigned short bf16;
typedef short bf16x8 __attribute__((ext_vector_type(8)));
typedef short s16x4 __attribute__((ext_vector_type(4)));
typedef float f32x2 __attribute__((ext_vector_type(2)));
typedef float f32x4 __attribute__((ext_vector_type(4)));
typedef float f32x16 __attribute__((ext_vector_type(16)));
typedef unsigned u32x2 __attribute__((ext_vector_type(2)));
typedef unsigned u32x4 __attribute__((ext_vector_type(4)));
typedef __bf16 bf16x2_t __attribute__((ext_vector_type(2)));

constexpr int T_TOK = 16384, DM = 1024, SEQ = 2048, NB = 8, NMEM = 256, MROWS = NB * NMEM, INC = 3584, FF = 4096;
constexpr float EPS = 1e-6f;
constexpr size_t MiB = 1u << 20;
constexpr size_t WS_W = 0, W_LAYER = 33 * MiB;
constexpr size_t WO_IN = 0, WO_MIX = 3584ull * 2048, WO_XQ = 4608ull * 2048, WO_XKV = 5632ull * 2048, WO_XO = 7680ull * 2048, WO_UP = 8704ull * 2048, WO_DOWN = 12800ull * 2048;
constexpr size_t WS_XB = 66 * MiB;
constexpr size_t WS_R1 = 98 * MiB;
constexpr size_t WS_O = WS_R1 + 32 * MiB;
constexpr size_t WS_KV = 226 * MiB;
constexpr size_t WS_MEMB = 234 * MiB;
constexpr size_t WS_XPART = 238 * MiB;
constexpr size_t WS_QPART = 239 * MiB;
constexpr size_t WS_KPART = 240 * MiB;
constexpr size_t WS_MPART = WS_KPART + 256 * 1024;
constexpr size_t WS_CTR = 241 * MiB;
constexpr size_t WS_PUB = WS_CTR + 32768;
constexpr size_t WS_BAR = WS_CTR + 4096;
constexpr size_t WS_XSS = WS_CTR + 65536;
constexpr size_t WS_MSS = WS_XSS + 7 * 65536;
constexpr size_t WS_CTL_BYTES = 65536 + 7 * 65536 + 8192;
constexpr size_t WS_END = 242 * MiB;
constexpr int LDS_BYTES = 147456, MISC_OFF = 131072;

__device__ __forceinline__ unsigned cvtpk(float lo, float hi) { f32x2 v = {lo, hi}; bf16x2_t b = __builtin_convertvector(v, bf16x2_t); return __builtin_bit_cast(unsigned, b); }
__device__ __forceinline__ float bf2f(unsigned short h) { return __uint_as_float(((unsigned)h) << 16); }
__device__ __forceinline__ float bflo(unsigned w) { return __uint_as_float(w << 16); }
__device__ __forceinline__ float bfhi(unsigned w) { return __uint_as_float(w & 0xffff0000u); }
__device__ __forceinline__ int tid_opaque() { int t = threadIdx.x; asm volatile("" : "+v"(t)); return t; }
__device__ __forceinline__ int crow(int r, int hi) { return (r & 3) + 8 * (r >> 2) + 4 * hi; }
__device__ __forceinline__ float wave_sum(float v) {
#pragma unroll
    for (int o = 1; o < 64; o <<= 1) v += __shfl_xor(v, o);
    return v;
}

template <int OFF> __device__ __forceinline__ void store16_wt(void* p, u32x4 v) { asm volatile("global_store_dwordx4 %0, %1, off offset:%2 sc1\n\ts_nop 1" :: "v"(p), "v"(v), "n"(OFF) : "memory"); }

namespace pg8 {
constexpr int BM = 256, BK = 64, HALF = 128, HTB = HALF * BK * 2, STAGE_BYTES = 8 * HTB, NXCD = 8, WGM = 8;
__host__ __device__ __forceinline__ int lds_byte(int r, int c) { const int st = (r >> 4) * 2 + (c >> 5), rr = r & 15, cc = c & 31, ob = rr * 64 + cc * 2; return st * 1024 + (ob ^ (((ob >> 9) & 1) << 5)); }
__host__ __device__ __forceinline__ void stage_rc(int b, int& R, int& C) { const int st = b / 1024, sb = b % 1024, swz = sb ^ (((sb >> 9) & 1) << 5); R = (st >> 1) * 16 + swz / 64; C = (st & 1) * 32 + (swz % 64) / 2; }
__host__ __device__ __forceinline__ int perm32(int rho) { const int n = rho >> 4, i = rho & 15; return 8 * (i >> 2) + 4 * n + (i & 3); }

struct Unit { int pm, pn; };
struct Gemm { const bf16* A; const bf16* Bt; int M, N, K, lda; int tj; long ajump; const float* hpart; int* pub = nullptr; };

struct StaticOrder {
    int nM, nN, nwg, G, c;
    __host__ __device__ void init(int M, int N, int G_, int c_) { nM = M / BM; nN = N / BM; nwg = nM * nN; G = G_; c = c_; }
    __host__ __device__ bool next(int i, Unit& u) const {
        const long L = (long)i * G + c; if (L >= nwg) return false;
        int wgid = (int)L; { const int q = nwg / NXCD, r = nwg % NXCD, xcd = wgid % NXCD, off = wgid / NXCD; wgid = (xcd < r ? xcd * (q + 1) : r * (q + 1) + (xcd - r) * q) + off; }
        const int nig = WGM * nN, gid = wgid / nig, fm = gid * WGM, gsz = (nM - fm) < WGM ? (nM - fm) : WGM;
        u.pm = fm + ((wgid % nig) % gsz); u.pn = (wgid % nig) / gsz; return true;
    }
};

enum { EM_PROJ = 0, EM_Q = 1, EM_UP = 2, EM_KV = 3 };
template <int MODE> struct EpiB {
    static constexpr bool PERM = true;
    bf16* O; int ldc; const float* part; float* opart;
    __device__ __forceinline__ void operator()(const f32x4 (&acc)[2][2][4][2], const Unit& u, int wr, int wc, int fr, int fq) const {
        const int row0 = u.pm * BM + wr * 64 + fr;
        const int colL = wc * 32 + 8 * fq;
        const int tt = u.pn >> 1;
        float inv[4];
        if (MODE == EM_PROJ) {
#pragma unroll
            for (int e = 0; e < 4; ++e) inv[e] = __builtin_amdgcn_exp2f(-(float)(16 * wc + 4 * fq + e) * (13.287712379549449f / 63.0f)) * 0.15915494309189535f;
        }
        float ssr[2][4];
#pragma unroll
        for (int ai = 0; ai < 2; ++ai)
#pragma unroll
            for (int m = 0; m < 4; ++m) ssr[ai][m] = part[row0 + ai * HALF + m * 16];
#pragma unroll
        for (int ai = 0; ai < 2; ++ai)
#pragma unroll
            for (int m = 0; m < 4; ++m) {
                const int row = row0 + ai * HALF + m * 16;
                const float rstd = rsqrtf(ssr[ai][m] * (1.0f / 1024.0f) + EPS);
                float sn[4], cs[4];
                if (MODE == EM_PROJ && tt <= 1) {
                    const float pos = (float)(row & (SEQ - 1));
#pragma unroll
                    for (int e = 0; e < 4; ++e) { const float rev = __builtin_amdgcn_fractf(pos * inv[e]); sn[e] = __builtin_amdgcn_sinf(rev); cs[e] = __builtin_amdgcn_cosf(rev); }
                }
                float sq = 0.f;
                bf16* rowp = O + (size_t)row * ldc + u.pn * BM + colL;
#pragma unroll
                for (int bj = 0; bj < 2; ++bj) {
                    f32x4 v0 = acc[ai][bj][m][0] * rstd, v1 = acc[ai][bj][m][1] * rstd;
                    if (MODE == EM_PROJ) {
                        if (tt <= 1) {
                            const float sc = (tt == 1) ? 0.08838834764831845f : 1.0f;
                            f32x4 a0, a1;
                            a0[0] = (v0[0] * cs[0] - v0[1] * sn[0]) * sc; a0[1] = (v0[0] * sn[0] + v0[1] * cs[0]) * sc;
                            a0[2] = (v0[2] * cs[1] - v0[3] * sn[1]) * sc; a0[3] = (v0[2] * sn[1] + v0[3] * cs[1]) * sc;
                            a1[0] = (v1[0] * cs[2] - v1[1] * sn[2]) * sc; a1[1] = (v1[0] * sn[2] + v1[1] * cs[2]) * sc;
                            a1[2] = (v1[2] * cs[3] - v1[3] * sn[3]) * sc; a1[3] = (v1[2] * sn[3] + v1[3] * cs[3]) * sc;
                            v0 = a0; v1 = a1;
                        } else if (tt == 3) {
#pragma unroll
                            for (int j = 0; j < 4; ++j) { v0[j] = v0[j] * __builtin_amdgcn_rcpf(1.0f + __builtin_amdgcn_exp2f(-1.4426950408889634f * v0[j])); v1[j] = v1[j] * __builtin_amdgcn_rcpf(1.0f + __builtin_amdgcn_exp2f(-1.4426950408889634f * v1[j])); }
                        } else if (tt == 4) { v0 = v0 * 0.18033688011112042f; v1 = v1 * 0.18033688011112042f; }
                    } else if (MODE == EM_UP) {
#pragma unroll
                        for (int j = 0; j < 4; ++j) { const float a = fmaxf(v0[j], 0.f), b = fmaxf(v1[j], 0.f); v0[j] = a * a; v1[j] = b * b; }
                    } else {
                        sq += (v0[0] * v0[0] + v0[1] * v0[1]) + (v0[2] * v0[2] + v0[3] * v0[3]) + (v1[0] * v1[0] + v1[1] * v1[1]) + (v1[2] * v1[2] + v1[3] * v1[3]);
                    }
                    u32x4 w; w.x = cvtpk(v0[0], v0[1]); w.y = cvtpk(v0[2], v0[3]); w.z = cvtpk(v1[0], v1[1]); w.w = cvtpk(v1[2], v1[3]);
                    if (bj == 0) store16_wt<0>(rowp, w); else store16_wt<HALF * 2>(rowp, w);
                }
                if (MODE == EM_Q || MODE == EM_KV) {
                    sq += __shfl_xor(sq, 16); sq += __shfl_xor(sq, 32);
                    if (fq == 0 && (MODE == EM_Q || u.pn < 4)) opart[(size_t)row * 16 + u.pn * 4 + wc] = sq;
                }
            }
    }
};
template <bool OUT_F32> struct EpiRes {
    static constexpr bool PERM = true;
    float* xout; bf16* xb; float* opart;
    __device__ __forceinline__ void operator()(const f32x4 (&acc)[2][2][4][2], const Unit& u, int wr, int wc, int fr, int fq) const {
        const int row0 = u.pm * BM + wr * 64 + fr, col0 = u.pn * BM + wc * 32 + 8 * fq;
        u32x4 xws[2][4][2];
#pragma unroll
        for (int ai = 0; ai < 2; ++ai)
#pragma unroll
            for (int m = 0; m < 4; ++m)
#pragma unroll
                for (int bj = 0; bj < 2; ++bj) xws[ai][m][bj] = *(const u32x4*)(xb + (size_t)(row0 + ai * HALF + m * 16) * DM + col0 + bj * HALF);
#pragma unroll
        for (int ai = 0; ai < 2; ++ai)
#pragma unroll
            for (int m = 0; m < 4; ++m) {
                const int row = row0 + ai * HALF + m * 16; const size_t off = (size_t)row * DM + col0; float sq = 0.f;
#pragma unroll
                for (int bj = 0; bj < 2; ++bj) {
                    const u32x4 xw = xws[ai][m][bj];
                    const f32x4 o0 = (f32x4){bflo(xw.x), bfhi(xw.x), bflo(xw.y), bfhi(xw.y)} + acc[ai][bj][m][0];
                    const f32x4 o1 = (f32x4){bflo(xw.z), bfhi(xw.z), bflo(xw.w), bfhi(xw.w)} + acc[ai][bj][m][1];
                    if (OUT_F32) { __builtin_nontemporal_store(o0, (f32x4*)(xout + off + bj * HALF)); __builtin_nontemporal_store(o1, (f32x4*)(xout + off + bj * HALF + 4)); }
                    u32x4 w; w.x = cvtpk(o0[0], o0[1]); w.y = cvtpk(o0[2], o0[3]); w.z = cvtpk(o1[0], o1[1]); w.w = cvtpk(o1[2], o1[3]);
                    if (bj == 0) store16_wt<0>(xb + off, w); else store16_wt<HALF * 2>(xb + off, w);
                    sq += ((o0[0] * o0[0] + o0[1] * o0[1]) + (o0[2] * o0[2] + o0[3] * o0[3])) + ((o1[0] * o1[0] + o1[1] * o1[1]) + (o1[2] * o1[2] + o1[3] * o1[3]));
                }
                sq += __shfl_xor(sq, 16); sq += __shfl_xor(sq, 32);
                if (fq == 0 && opart) unsafeAtomicAdd(opart + row, sq);
            }
    }
};

template <int HOOK = 0, bool PUB = false, class Epi, class Sched, bool ALIGN_EPI = true>
__device__ __forceinline__ void gemm_phase(LAS unsigned char* lds, const Gemm g, const Sched& S, const Epi& E) {
    const int tid = tid_opaque(), wid = __builtin_amdgcn_readfirstlane(tid >> 6), lane = tid & 63, wr = wid >> 2, wc = wid & 3, fr = lane & 15, fq = lane >> 4;
    const int K = g.K, nt = K / BK, lda = g.lda, tj = g.tj; const long ajump = g.ajump;
#define PG8_AO(tt) ((long)(tt) * (long)kstep + ((tt) >= tj ? ajump : 0l))
    unsigned voffA[2], voffB[2];
#pragma unroll
    for (int i = 0; i < 2; ++i) { int R, C; stage_rc(tid * 16 + i * 8192, R, C); const int Rb = Epi::PERM ? ((R & ~31) + perm32(R & 31)) : R;
        voffA[i] = (unsigned)(R * lda + C) * 2u; voffB[i] = (unsigned)(Rb * K + C) * 2u; }
    const size_t kstep = (size_t)(BK * 2);
    const size_t hstepA = (size_t)HALF * lda * 2, hstepB = (size_t)HALF * K * 2;
    const size_t tstepA = 2 * hstepA, tstepB = 2 * hstepB;
    const unsigned ldsw = (unsigned)wid * 1024u;
    const int aoff = lds_byte(wr * 64 + fr, fq * 8), boff = lds_byte(wc * 32 + fr, fq * 8);
#define PG8_SA(b, h) (((b) * 2 + (h)) * HTB)
#define PG8_SB(b, h) ((4 + (b) * 2 + (h)) * HTB)
#define PG8_STAGE(bufoff, gbase, voff) do { _Pragma("unroll") for (int _i = 0; _i < 2; ++_i) \
        __builtin_amdgcn_global_load_lds((const unsigned*)((const char*)(gbase) + (voff)[_i]), (LAS unsigned*)(lds + (bufoff) + ldsw + _i * 8192), 16, 0, 0); } while (0)
#define PG8_LDA(dst, b, h) do { _Pragma("unroll") for (int m = 0; m < 4; ++m) _Pragma("unroll") for (int k = 0; k < 2; ++k) dst[m][k] = *(const LAS bf16x8*)(lds + PG8_SA(b, h) + aoff + m * 2048 + k * 1024); } while (0)
#define PG8_LDB(dst, b, h) do { _Pragma("unroll") for (int n = 0; n < 2; ++n) _Pragma("unroll") for (int k = 0; k < 2; ++k) dst[n][k] = *(const LAS bf16x8*)(lds + PG8_SB(b, h) + boff + n * 2048 + k * 1024); } while (0)
#define PG8_MMA(ai, bj, At, Bt) do { __builtin_amdgcn_s_setprio(1); _Pragma("unroll") for (int m = 0; m < 4; ++m) _Pragma("unroll") for (int n = 0; n < 2; ++n) _Pragma("unroll") for (int k = 0; k < 2; ++k) \
        acc[ai][bj][m][n] = __builtin_amdgcn_mfma_f32_16x16x32_bf16(Bt[n][k], At[m][k], acc[ai][bj][m][n], 0, 0, 0); __builtin_amdgcn_s_setprio(0); } while (0)
#define PG8_WAIT_V(n) asm volatile("s_waitcnt vmcnt(" #n ")" ::: "memory")
#define PG8_WAIT_L(n) asm volatile("s_waitcnt lgkmcnt(" #n ")" ::: "memory")
#define PG8_BAR __builtin_amdgcn_s_barrier()
#define PG8_SCHED __builtin_amdgcn_sched_barrier(0)
    Unit cur, nxt; int ui = 0; int prev_pm = 0; (void)prev_pm;
    if (!S.next(0, cur)) return;
    f32x4 acc[2][2][4][2];
#pragma unroll
    for (int a = 0; a < 2; ++a)
#pragma unroll
        for (int b = 0; b < 2; ++b)
#pragma unroll
            for (int m = 0; m < 4; ++m)
#pragma unroll
                for (int n = 0; n < 2; ++n) acc[a][b][m][n] = (f32x4){0.f, 0.f, 0.f, 0.f};
    bf16x8 At[4][2], B0[2][2], B1[2][2];
    const char* cA = (const char*)g.A + (size_t)cur.pm * tstepA; const char* cB = (const char*)g.Bt + (size_t)cur.pn * tstepB;
    PG8_STAGE(PG8_SB(0, 0), cB, voffB); PG8_STAGE(PG8_SB(0, 1), cB + hstepB, voffB); PG8_STAGE(PG8_SA(0, 0), cA, voffA); PG8_STAGE(PG8_SA(0, 1), cA + hstepA, voffA);
    if (wr == 1) PG8_BAR;
    PG8_WAIT_V(2); PG8_BAR;
    PG8_STAGE(PG8_SB(1, 0), cB + kstep, voffB); PG8_STAGE(PG8_SA(1, 0), cA + kstep, voffA); PG8_STAGE(PG8_SB(1, 1), cB + hstepB + kstep, voffB);
    PG8_WAIT_V(6); PG8_BAR;
    for (;;) {
        const bool has_next = S.next(ui + 1, nxt);
        const char* nA = has_next ? (const char*)g.A + (size_t)nxt.pm * tstepA : cA; const char* nB = has_next ? (const char*)g.Bt + (size_t)nxt.pn * tstepB : cB;
        for (int t = 0; t < nt; t += 2) {
            const bool last = (t == nt - 2);
            const char* a1 = cA + PG8_AO(t + 1);
            const char* a2 = last ? nA : cA + PG8_AO(t + 2); const char* b2 = last ? nB : cB + (size_t)(t + 2) * kstep;
            const char* a3 = last ? nA + kstep : cA + PG8_AO(t + 3); const char* b3 = b2 + kstep;
            if constexpr (HOOK != 0) {
                if (t == tj) {
                    int fro = fr; asm volatile("" : "+v"(fro));
#pragma unroll
                    for (int ai = 0; ai < 2; ++ai)
#pragma unroll
                        for (int m = 0; m < 4; ++m) {
                            float rs;
                            if constexpr (HOOK == 2) rs = ((const LAS float*)(lds + MISC_OFF + 1024))[ai * HALF + wr * 64 + m * 16 + fro];
                            else { const int row = cur.pm * BM + ai * HALF + wr * 64 + m * 16 + fro;
                                const f32x4 s0 = *(const f32x4*)(g.hpart + (size_t)row * 8), s1 = *(const f32x4*)(g.hpart + (size_t)row * 8 + 4);
                                rs = rsqrtf((((s0[0] + s0[1]) + (s0[2] + s0[3])) + ((s1[0] + s1[1]) + (s1[2] + s1[3]))) * (1.0f / 512.0f) + EPS); }
#pragma unroll
                            for (int bj = 0; bj < 2; ++bj)
#pragma unroll
                                for (int n = 0; n < 2; ++n) acc[ai][bj][m][n] = acc[ai][bj][m][n] * rs;
                        }
                }
            }
            PG8_LDB(B0, 0, 0); PG8_LDB(B1, 0, 1); PG8_SCHED; PG8_LDA(At, 0, 0); PG8_STAGE(PG8_SA(1, 1), a1 + hstepA, voffA);
            PG8_WAIT_V(8); PG8_WAIT_L(0); PG8_BAR; PG8_MMA(0, 0, At, B0); PG8_MMA(0, 1, At, B1); PG8_BAR; PG8_SCHED;
            PG8_LDA(At, 0, 1); PG8_STAGE(PG8_SB(0, 0), b2, voffB); PG8_STAGE(PG8_SB(0, 1), b2 + hstepB, voffB); PG8_STAGE(PG8_SA(0, 0), a2, voffA);
            PG8_WAIT_V(8); PG8_WAIT_L(0); PG8_BAR; PG8_MMA(1, 0, At, B0); PG8_MMA(1, 1, At, B1); PG8_BAR; PG8_SCHED;
            PG8_LDB(B0, 1, 0); PG8_LDB(B1, 1, 1); PG8_SCHED; PG8_LDA(At, 1, 0); PG8_STAGE(PG8_SA(0, 1), a2 + hstepA, voffA);
            PG8_WAIT_V(8); PG8_WAIT_L(0); PG8_BAR; PG8_MMA(0, 0, At, B0); PG8_MMA(0, 1, At, B1); PG8_BAR; PG8_SCHED;
            PG8_LDA(At, 1, 1); PG8_STAGE(PG8_SB(1, 0), b3, voffB); PG8_STAGE(PG8_SB(1, 1), b3 + hstepB, voffB); PG8_STAGE(PG8_SA(1, 0), a3, voffA);
            PG8_WAIT_V(8); PG8_WAIT_L(0); PG8_BAR; PG8_MMA(1, 0, At, B0); PG8_MMA(1, 1, At, B1); PG8_BAR; PG8_SCHED;
        }
        if constexpr (ALIGN_EPI) { if (wr == 0) PG8_BAR; }
        E(acc, cur, wr, wc, fr, fq);
        if (!has_next) break;
#pragma unroll
        for (int a = 0; a < 2; ++a)
#pragma unroll
            for (int b = 0; b < 2; ++b)
#pragma unroll
                for (int m = 0; m < 4; ++m)
#pragma unroll
                    for (int n = 0; n < 2; ++n) acc[a][b][m][n] = (f32x4){0.f, 0.f, 0.f, 0.f};
        cur = nxt; cA = nA; cB = nB; ++ui;
        if constexpr (ALIGN_EPI) { if (wr == 1) PG8_BAR; }
    }
    PG8_WAIT_V(0);
    if constexpr (PUB) {
        Unit up; for (int i = 0; S.next(i, up); ++i) if (lane == 0) __hip_atomic_fetch_add(g.pub + 64 * up.pm, 1, __ATOMIC_RELAXED, __HIP_MEMORY_SCOPE_AGENT);
    }
    if constexpr (!ALIGN_EPI) { if (wr == 0) PG8_BAR; }
    PG8_BAR;
#undef PG8_AO
#undef PG8_SA
#undef PG8_SB
#undef PG8_STAGE
#undef PG8_LDA
#undef PG8_LDB
#undef PG8_MMA
#undef PG8_WAIT_V
#undef PG8_WAIT_L
#undef PG8_BAR
#undef PG8_SCHED
}
}

__device__ __forceinline__ void transpose_item(const float* W, int K, int N, bf16* WT, const float* g, bool permq, LAS float* scr, int item, int lane, int gk0 = 0, int krot = 0) {
    const int nblk = N / 64, kb = item / nblk, nb = item % nblk, k0 = 32 * kb, n0 = 64 * nb;
    const int kr = lane >> 4, nc = (lane & 15) * 4;
    f32x4 v[8];
#pragma unroll
    for (int i = 0; i < 8; ++i) v[i] = __builtin_nontemporal_load((const f32x4*)(W + (size_t)(k0 + 4 * i + kr) * N + n0 + nc));
    if (g && k0 >= gk0) {
#pragma unroll
        for (int i = 0; i < 8; ++i) v[i] = v[i] * g[k0 - gk0 + 4 * i + kr];
    }
#pragma unroll
    for (int i = 0; i < 8; ++i) { LAS float* d = scr + (4 * i + kr) * 66 + nc; *(LAS f32x2*)d = (f32x2){v[i][0], v[i][1]}; *(LAS f32x2*)(d + 2) = (f32x2){v[i][2], v[i][3]}; }
    asm volatile("s_waitcnt lgkmcnt(0)" ::: "memory");
    const int c = lane >> 4;
#pragma unroll
    for (int j = 0; j < 4; ++j) { const int n = (lane & 15) + 16 * j; const LAS float* s = scr + (8 * c) * 66 + n;
        u32x4 o; o.x = cvtpk(s[0 * 66], s[1 * 66]); o.y = cvtpk(s[2 * 66], s[3 * 66]); o.z = cvtpk(s[4 * 66], s[5 * 66]); o.w = cvtpk(s[6 * 66], s[7 * 66]);
        int nn = n0 + n;
        if (permq && nn < 1024) { const int hd = nn >> 7, i = nn & 127; nn = hd * 128 + (i < 64 ? 2 * i : 2 * (i - 64) + 1); }
        *(u32x4*)(WT + (size_t)nn * K + ((k0 + krot) & (K - 1)) + 8 * c) = o; }
    asm volatile("s_waitcnt lgkmcnt(0)" ::: "memory");
}
__device__ __forceinline__ void rows2_to_bf16(const float* xrow, bf16* orow, float* prow, int lane) {
    const f32x4* xr = (const f32x4*)xrow + lane;
    f32x4 v[8]; float s0 = 0.f, s1 = 0.f;
#pragma unroll
    for (int j = 0; j < 8; ++j) v[j] = __builtin_nontemporal_load(xr + 64 * j);
#pragma unroll
    for (int j = 0; j < 4; ++j) { s0 += (v[j][0] * v[j][0] + v[j][1] * v[j][1]) + (v[j][2] * v[j][2] + v[j][3] * v[j][3]); s1 += (v[j + 4][0] * v[j + 4][0] + v[j + 4][1] * v[j + 4][1]) + (v[j + 4][2] * v[j + 4][2] + v[j + 4][3] * v[j + 4][3]); }
#pragma unroll
    for (int o = 1; o < 64; o <<= 1) { s0 += __shfl_xor(s0, o); s1 += __shfl_xor(s1, o); }
    u32x2* o8 = (u32x2*)orow + lane;
#pragma unroll
    for (int j = 0; j < 8; ++j) { u32x2 w; w.x = cvtpk(v[j][0], v[j][1]); w.y = cvtpk(v[j][2], v[j][3]); o8[64 * j] = w; }
    if (lane < 2) prow[lane] = (lane == 0) ? s0 : s1;
}

#define MFMA32(a, b, c) __builtin_amdgcn_mfma_f32_32x32x16_bf16((a), (b), (c), 0, 0, 0)
typedef short v4i16_t __attribute__((ext_vector_type(4)));
__device__ __forceinline__ s16x4 vtr(const LAS unsigned char* p) { return __builtin_bit_cast(s16x4, __builtin_amdgcn_ds_read_tr16_b64_v4i16((LAS v4i16_t*)p)); }
#define PACK8(x, s) ((u32x4){cvtpk((x)[8 * (s)], (x)[8 * (s) + 1]), cvtpk((x)[8 * (s) + 2], (x)[8 * (s) + 3]), cvtpk((x)[8 * (s) + 4], (x)[8 * (s) + 5]), cvtpk((x)[8 * (s) + 6], (x)[8 * (s) + 7])})

template <bool MASK>
__device__ __forceinline__ void sb_block(f32x16& X, int kb, int t, int hi, float& carry) {
    float e[16], m[16];
#pragma unroll
    for (int r = 0; r < 16; ++r) {
        e[r] = __builtin_amdgcn_exp2f(fminf(X[r], 80.0f));
        m[r] = __builtin_amdgcn_rcpf(1.0f + e[r]);
        if (MASK) { if (!(kb + crow(r, hi) < t)) { m[r] = 1.0f; e[r] = 0.f; } }
    }
    float b[4], ob[4];
#pragma unroll
    for (int g = 0; g < 4; ++g) { b[g] = (m[4 * g] * m[4 * g + 1]) * (m[4 * g + 2] * m[4 * g + 3]); ob[g] = __shfl_xor(b[g], 32); }
    float run = carry;
#pragma unroll
    for (int g = 3; g >= 0; --g) {
        const float suf = (hi == 0) ? run * ob[g] : run;
        const float c3 = m[4 * g + 3] * suf, c2 = m[4 * g + 2] * c3, c1 = m[4 * g + 1] * c2, c0 = m[4 * g] * c1;
        X[4 * g + 3] = e[4 * g + 3] * c3; X[4 * g + 2] = e[4 * g + 2] * c2; X[4 * g + 1] = e[4 * g + 1] * c1; X[4 * g] = e[4 * g] * c0;
        run *= b[g] * ob[g];
    }
    carry = run;
}
__device__ __forceinline__ void ret_block(f32x16& X, int kb, int t, int hi, float lg2) {
#pragma unroll
    for (int r = 0; r < 16; ++r) { const float d = fabsf((float)(t - (kb + crow(r, hi)))); X[r] *= __builtin_amdgcn_exp2f(lg2 * d); }
}
__device__ __forceinline__ void ret_block_f(f32x16& X, float f, float g1, float g8) {
    float fj = f;
#pragma unroll
    for (int j = 0; j < 4; ++j) { float fi = fj;
#pragma unroll
        for (int i = 0; i < 4; ++i) { X[4 * j + i] *= fi; fi *= g1; }
        fj *= g8; }
}

__device__ __forceinline__ u32x4 widen_pair(u32x2 a, u32x2 b) {
    const auto s0 = __builtin_amdgcn_permlane32_swap(a.x, b.x, false, false);
    const auto s1 = __builtin_amdgcn_permlane32_swap(a.y, b.y, false, false);
    return (u32x4){s0[0], s1[0], s0[1], s1[1]};
}
__device__ __forceinline__ void glds16(const void* gsrc, unsigned lds_dst) { unsigned keep;
    asm volatile("s_mov_b32 %0, m0\n\ts_mov_b32 m0, %2\n\ts_nop 0\n\tglobal_load_lds_dwordx4 %1, off\n\ts_mov_b32 m0, %0" : "=&s"(keep) : "v"(gsrc), "s"(lds_dst) : "memory"); }

template <int HD, bool SB>
__device__ __forceinline__ void attn_unit(LAS unsigned char* lds, bf16* P, int b, int h, int qb, float lg2, const float* gret, float* sbpart) {
    constexpr int PITCH = INC, NS = HD / 16, ND = HD / 32, RB = HD * 2, NC = HD / 8, NC64 = HD / 32, KBYTES = 64 * RB;
    const int tid = tid_opaque(), lane = tid & 63, w = __builtin_amdgcn_readfirstlane(tid >> 6), r32 = lane & 31, hi = lane >> 5;
    const int qcol = SB ? 2048 + h * 64 : h * 128, kcol = SB ? 2560 + h * 64 : 512 + h * 128, vcol = SB ? 3072 + h * 64 : 1024 + h * 128;
    const size_t rowbase = (size_t)b * SEQ;
    const int q0 = qb * 256, tq = q0 + 32 * w + r32, wlo = q0 + 32 * w;
    bf16x8 qf[NS];
    { const bf16* qp = P + (rowbase + tq) * PITCH + qcol + hi * 8;
#pragma unroll
      for (int s = 0; s < NS; ++s) qf[s] = *(const bf16x8*)(qp + 16 * s); }
#pragma unroll
    for (int s = 0; s < NS; ++s) asm volatile("" : "+v"(qf[s]));
    f32x16 o[ND];
#pragma unroll
    for (int d = 0; d < ND; ++d)
#pragma unroll
        for (int r = 0; r < 16; ++r) o[d][r] = 0.f;
    float carry = SB ? 1.0f : 0.f;
    float g1 = 1.f, g8 = 1.f, c32 = 1.f;
    if (!SB) { g1 = __builtin_amdgcn_exp2f(-lg2); g8 = __builtin_amdgcn_exp2f(-8.0f * lg2); c32 = __builtin_amdgcn_exp2f(-32.0f * lg2); }
    const int NT = 4 * (qb + 1);
    constexpr int TILEB = 2 * KBYTES, PIECES = TILEB / 1024, PPW = PIECES / 8, RPP = 1024 / RB;
    const int rip = lane / NC, pos = lane % NC;
    const unsigned lds0 = (unsigned)(uintptr_t)lds;
#define AT_DMA(kt, slot) do { _Pragma("unroll") for (int i_ = 0; i_ < PPW; ++i_) { const int pc_ = w * PPW + i_, mat_ = pc_ / (PIECES / 2), pim_ = pc_ % (PIECES / 2), row_ = pim_ * RPP + rip; \
        const int c_ = mat_ ? ((((pos >> 2) ^ (row_ & (NC64 - 1))) << 2) | (pos & 3)) : (pos ^ (row_ & (NC - 1))); \
        glds16(P + (rowbase + 64 * (kt) + row_) * PITCH + (mat_ ? vcol : kcol) + 8 * c_, (unsigned)__builtin_amdgcn_readfirstlane((int)(lds0 + (slot) * TILEB + mat_ * KBYTES + pim_ * 1024))); } } while (0)
    __syncthreads();
#define AT_TILE(j) (SB ? NT - 1 - (j) : (j))
    AT_DMA(AT_TILE(0), 0); AT_DMA(AT_TILE(1), 1); AT_DMA(AT_TILE(2), 2);
    int cur = 0;
    const int blk = (lane >> 4) & 1, p4 = lane & 3, q4 = (lane & 15) >> 2;
    volatile LAS int* flg = (volatile LAS int*)(lds + MISC_OFF + 64);
    bool wdone = false;
    for (int j = 0; j < NT; ++j, cur = (cur + 1) & 3) {
        const int kt = AT_TILE(j);
        if (j + 2 < NT) { if (PPW == 2) asm volatile("s_waitcnt vmcnt(4)" ::: "memory"); else asm volatile("s_waitcnt vmcnt(8)" ::: "memory"); }
        else if (j + 1 < NT) { if (PPW == 2) asm volatile("s_waitcnt vmcnt(2)" ::: "memory"); else asm volatile("s_waitcnt vmcnt(4)" ::: "memory"); }
        else asm volatile("s_waitcnt vmcnt(0)" ::: "memory");
        if (SB && lane == 0) flg[(kt & 1) * 8 + w] = wdone ? 1 : 0;
        __syncthreads();
        if (SB) { const LAS int* f4 = (const LAS int*)(lds + MISC_OFF + 64 + (kt & 1) * 32); const int a0 = f4[0] & f4[1] & f4[2] & f4[3] & f4[4] & f4[5] & f4[6] & f4[7]; if (a0) break; }
        if (j + 3 < NT) AT_DMA(AT_TILE(j + 3), (cur + 3) & 3);
        const bool part = SB ? (64 * kt < wlo + 31 && !wdone) : (kt <= (wlo >> 6));
        if (part) {
            const LAS unsigned char* Kb = lds + cur * TILEB; const LAS unsigned char* Vb = Kb + KBYTES;
            f32x16 p0, p1;
#pragma unroll
            for (int r = 0; r < 16; ++r) { p0[r] = 0.f; p1[r] = 0.f; }
#pragma unroll
            for (int sb = 0; sb < NS / 4; ++sb) {
                bf16x8 kf0[4], kf1[4];
#pragma unroll
                for (int i = 0; i < 4; ++i) { const int c = 2 * (4 * sb + i) + hi;
                    kf0[i] = *(const LAS bf16x8*)(Kb + r32 * RB + ((c ^ (r32 & (NC - 1))) << 4));
                    kf1[i] = *(const LAS bf16x8*)(Kb + (32 + r32) * RB + ((c ^ (r32 & (NC - 1))) << 4)); }
                __builtin_amdgcn_sched_barrier(0);
#pragma unroll
                for (int i = 0; i < 4; ++i) { p0 = MFMA32(kf0[i], qf[4 * sb + i], p0); p1 = MFMA32(kf1[i], qf[4 * sb + i], p1); }
                __builtin_amdgcn_sched_barrier(0);
            }
            s16x4 vl[ND][4], vh[ND][4];
            if (SB) {
#pragma unroll
                for (int d0 = 0; d0 < ND; ++d0)
#pragma unroll
                    for (int ks = 0; ks < 4; ++ks) { const int rowA = 16 * ks + 4 * hi + q4, rowB = rowA + 8;
                        vl[d0][ks] = vtr(Vb + rowA * RB + ((d0 ^ (rowA & (NC64 - 1))) << 6) + 32 * blk + 8 * p4);
                        vh[d0][ks] = vtr(Vb + rowB * RB + ((d0 ^ (rowB & (NC64 - 1))) << 6) + 32 * blk + 8 * p4); }
                __builtin_amdgcn_sched_barrier(0);
            }
            if (SB) {
                if (64 * kt + 63 < wlo) { sb_block<false>(p1, 64 * kt + 32, tq, hi, carry); sb_block<false>(p0, 64 * kt, tq, hi, carry); }
                else { sb_block<true>(p1, 64 * kt + 32, tq, hi, carry); sb_block<true>(p0, 64 * kt, tq, hi, carry); }
                wdone = __all(carry < 1e-37f) != 0;
            } else if (kt == (wlo >> 6)) { ret_block(p1, 64 * kt + 32, tq, hi, lg2); ret_block(p0, 64 * kt, tq, hi, lg2); }
            else { const float f0 = __builtin_amdgcn_exp2f(lg2 * (float)(tq - 64 * kt - 4 * hi)); ret_block_f(p0, f0, g1, g8); ret_block_f(p1, f0 * c32, g1, g8); }
            bf16x8 pa[4];
            pa[0] = __builtin_bit_cast(bf16x8, PACK8(p0, 0)); pa[1] = __builtin_bit_cast(bf16x8, PACK8(p0, 1));
            pa[2] = __builtin_bit_cast(bf16x8, PACK8(p1, 0)); pa[3] = __builtin_bit_cast(bf16x8, PACK8(p1, 1));
#pragma unroll
            for (int ks = 0; ks < 4; ++ks) {
                if (!SB) {
                    const int rowA = 16 * ks + 4 * hi + q4, rowB = rowA + 8;
#pragma unroll
                    for (int d0 = 0; d0 < ND; ++d0) {
                        vl[d0][ks] = vtr(Vb + rowA * RB + ((d0 ^ (rowA & (NC64 - 1))) << 6) + 32 * blk + 8 * p4);
                        vh[d0][ks] = vtr(Vb + rowB * RB + ((d0 ^ (rowB & (NC64 - 1))) << 6) + 32 * blk + 8 * p4); }
                    __builtin_amdgcn_sched_barrier(0);
                }
#pragma unroll
                for (int d0 = 0; d0 < ND; ++d0) {
                    const bf16x8 vf = __builtin_shufflevector(vl[d0][ks], vh[d0][ks], 0, 1, 2, 3, 4, 5, 6, 7);
                    o[d0] = MFMA32(vf, pa[ks], o[d0]);
                }
                if (!SB) __builtin_amdgcn_sched_barrier(0);
            }
        }
    }
#undef AT_DMA
#undef AT_TILE
    asm volatile("s_waitcnt vmcnt(0)" ::: "memory");
    bf16* orow = P + (rowbase + wlo + r32) * PITCH + qcol + 4 * hi;
    float ss = 0.f;
#pragma unroll
    for (int d0 = 0; d0 < ND; ++d0)
#pragma unroll
        for (int r = 0; r < 16; ++r) ss += o[d0][r] * o[d0][r];
    ss += __shfl_xor(ss, 32);
    if (SB) {
        if (hi == 0) sbpart[(rowbase + wlo + r32) * 8 + h] = ss;
#pragma unroll
        for (int d0 = 0; d0 < ND; ++d0)
#pragma unroll
            for (int k = 0; k < 2; ++k) { u32x2 wa, wb; wa.x = cvtpk(o[d0][8 * k], o[d0][8 * k + 1]); wa.y = cvtpk(o[d0][8 * k + 2], o[d0][8 * k + 3]); wb.x = cvtpk(o[d0][8 * k + 4], o[d0][8 * k + 5]); wb.y = cvtpk(o[d0][8 * k + 6], o[d0][8 * k + 7]);
                *(u32x4*)(orow + 32 * d0 + 16 * k + 4 * hi) = widen_pair(wa, wb); }
    } else {
        const float rs = rsqrtf(ss * (1.0f / 128.0f) + EPS);
        u32x2 gt[ND][4]; f32x4 gr[ND][4];
#pragma unroll
        for (int d0 = 0; d0 < ND; ++d0)
#pragma unroll
            for (int g = 0; g < 4; ++g) { gt[d0][g] = *(const u32x2*)(orow + 1536 + 32 * d0 + 8 * g); gr[d0][g] = *(const f32x4*)(gret + h * 128 + 32 * d0 + 8 * g + 4 * hi); }
#pragma unroll
        for (int d0 = 0; d0 < ND; ++d0)
#pragma unroll
            for (int k = 0; k < 2; ++k) {
                u32x2 wv[2];
#pragma unroll
                for (int gi = 0; gi < 2; ++gi) { const int g = 2 * k + gi; const f32x4 gg = gr[d0][g] * rs;
                    wv[gi].x = cvtpk(o[d0][4 * g] * gg[0] * bflo(gt[d0][g].x), o[d0][4 * g + 1] * gg[1] * bfhi(gt[d0][g].x));
                    wv[gi].y = cvtpk(o[d0][4 * g + 2] * gg[2] * bflo(gt[d0][g].y), o[d0][4 * g + 3] * gg[3] * bfhi(gt[d0][g].y)); }
                *(u32x4*)(orow + 32 * d0 + 16 * k + 4 * hi) = widen_pair(wv[0], wv[1]);
            }
    }
}

__device__ __forceinline__ void sb_unit(LAS unsigned char* lds, bf16* P, int b, int h, int qb, float* sbpart) {
    constexpr int PITCH = INC, NS = 4, ND = 2, RB = 128;
    const int tid = tid_opaque(), lane = tid & 63, w = __builtin_amdgcn_readfirstlane(tid >> 6), r32 = lane & 31, hi = lane >> 5;
    const int qcol = 2048 + h * 64, kcol = 2560 + h * 64, vcol = 3072 + h * 64;
    const size_t rowbase = (size_t)b * SEQ;
    const int q0 = qb * 256, wlo = q0 + 32 * w, tq = wlo + r32;
    bf16x8 qf[NS];
    { const bf16* qp = P + (rowbase + tq) * PITCH + qcol + hi * 8;
#pragma unroll
      for (int s = 0; s < NS; ++s) qf[s] = *(const bf16x8*)(qp + 16 * s); }
#pragma unroll
    for (int s = 0; s < NS; ++s) asm volatile("" : "+v"(qf[s]));
    f32x16 o[ND];
#pragma unroll
    for (int d = 0; d < ND; ++d)
#pragma unroll
        for (int r = 0; r < 16; ++r) o[d][r] = 0.f;
    float carry = 1.0f;
    const unsigned wbase = (unsigned)(uintptr_t)lds + (unsigned)w * 16384u;
    const LAS unsigned char* wl = lds + w * 16384;
    const int rip = lane >> 3, pos = lane & 7;
#define SB_DMA(hb, slot) do { _Pragma("unroll") for (int pc_ = 0; pc_ < 8; ++pc_) { const int mat_ = pc_ >> 2, row_ = 8 * (pc_ & 3) + rip; \
        const int c_ = mat_ ? ((((pos >> 2) ^ (row_ & 1)) << 2) | (pos & 3)) : (pos ^ (row_ & 7)); \
        glds16(P + (rowbase + 32 * (hb) + row_) * PITCH + (mat_ ? vcol : kcol) + 8 * c_, (unsigned)__builtin_amdgcn_readfirstlane((int)(wbase + (slot) * 8192 + mat_ * 4096 + (pc_ & 3) * 1024))); } } while (0)
    const int hb0 = wlo >> 5;
    __syncthreads();
    SB_DMA(hb0, 0);
    const int blk = (lane >> 4) & 1, p4 = lane & 3, q4 = (lane & 15) >> 2;
    int sl = 0;
    for (int hb = hb0; hb >= 0; --hb, sl ^= 1) {
        if (hb > 0) { SB_DMA(hb - 1, sl ^ 1); asm volatile("s_waitcnt vmcnt(8)" ::: "memory"); }
        else asm volatile("s_waitcnt vmcnt(0)" ::: "memory");
        const LAS unsigned char* Kb = wl + sl * 8192; const LAS unsigned char* Vb = Kb + 4096;
        f32x16 p;
#pragma unroll
        for (int r = 0; r < 16; ++r) p[r] = 0.f;
        bf16x8 kf[NS];
#pragma unroll
        for (int s = 0; s < NS; ++s) kf[s] = *(const LAS bf16x8*)(Kb + r32 * RB + (((2 * s + hi) ^ (r32 & 7)) << 4));
        s16x4 vl[ND][2], vh[ND][2];
#pragma unroll
        for (int d0 = 0; d0 < ND; ++d0)
#pragma unroll
            for (int ks = 0; ks < 2; ++ks) { const int rowA = 16 * ks + 4 * hi + q4, rowB = rowA + 8;
                vl[d0][ks] = vtr(Vb + rowA * RB + ((d0 ^ (rowA & 1)) << 6) + 32 * blk + 8 * p4);
                vh[d0][ks] = vtr(Vb + rowB * RB + ((d0 ^ (rowB & 1)) << 6) + 32 * blk + 8 * p4); }
#pragma unroll
        for (int s = 0; s < NS; ++s) p = MFMA32(kf[s], qf[s], p);
        if (32 * hb + 31 < wlo) sb_block<false>(p, 32 * hb, tq, hi, carry); else sb_block<true>(p, 32 * hb, tq, hi, carry);
        bf16x8 pa[2];
        pa[0] = __builtin_bit_cast(bf16x8, PACK8(p, 0)); pa[1] = __builtin_bit_cast(bf16x8, PACK8(p, 1));
#pragma unroll
        for (int ks = 0; ks < 2; ++ks)
#pragma unroll
            for (int d0 = 0; d0 < ND; ++d0) {
                const bf16x8 vf = __builtin_shufflevector(vl[d0][ks], vh[d0][ks], 0, 1, 2, 3, 4, 5, 6, 7);
                o[d0] = MFMA32(vf, pa[ks], o[d0]);
            }
        if (__all(carry < 1e-37f)) break;
    }
#undef SB_DMA
    asm volatile("s_waitcnt vmcnt(0)" ::: "memory");
    bf16* orow = P + (rowbase + wlo + r32) * PITCH + qcol + 4 * hi;
    float ss = 0.f;
#pragma unroll
    for (int d0 = 0; d0 < ND; ++d0)
#pragma unroll
        for (int r = 0; r < 16; ++r) ss += o[d0][r] * o[d0][r];
    ss += __shfl_xor(ss, 32);
    if (hi == 0) sbpart[(rowbase + wlo + r32) * 8 + h] = ss;
#pragma unroll
    for (int d0 = 0; d0 < ND; ++d0)
#pragma unroll
        for (int k = 0; k < 2; ++k) { u32x2 wa, wb; wa.x = cvtpk(o[d0][8 * k], o[d0][8 * k + 1]); wa.y = cvtpk(o[d0][8 * k + 2], o[d0][8 * k + 3]); wb.x = cvtpk(o[d0][8 * k + 4], o[d0][8 * k + 5]); wb.y = cvtpk(o[d0][8 * k + 6], o[d0][8 * k + 7]);
            *(u32x4*)(orow + 32 * d0 + 16 * k + 4 * hi) = widen_pair(wa, wb); }
}

__device__ __forceinline__ void xattn_unit(LAS unsigned char* lds, const bf16* Q, const bf16* KV, const float* qpart, bf16* O, int b, int h, int tb) {
    const int tid = tid_opaque(), lane = tid & 63, w = __builtin_amdgcn_readfirstlane(tid >> 6), r32 = lane & 31, hi = lane >> 5;
    const size_t Rw = (size_t)b * SEQ + tb * 256 + 32 * w, R = Rw + r32;
    const bf16* kvb = KV + (size_t)b * NMEM * 2048 + h * 256;
    const unsigned ldsb = (unsigned)(uintptr_t)lds; const int rip = lane >> 5, pos = lane & 31;
    __syncthreads();
#pragma unroll
    for (int i = 0; i < 16; ++i) { const int pim = w * 16 + i, row = 2 * pim + rip, c = pos ^ (row & 31);
        glds16(kvb + (size_t)row * 2048 + c * 8, (unsigned)__builtin_amdgcn_readfirstlane((int)(ldsb + pim * 1024))); }
    asm volatile("s_waitcnt vmcnt(0)" ::: "memory");
    __syncthreads();
    const bf16* qp = Q + R * DM + h * 256 + hi * 8;
    const f32x4 qq = *(const f32x4*)(qpart + R * 16 + h * 4);
    const float rq = rsqrtf(((qq[0] + qq[1]) + (qq[2] + qq[3])) * (1.0f / 256.0f) + EPS);
    float l = 0.f; bf16x8 pa[8][2];
#pragma unroll
    for (int half = 0; half < 2; ++half) {
        f32x16 p[4];
#pragma unroll
        for (int kb = 0; kb < 4; ++kb)
#pragma unroll
            for (int r = 0; r < 16; ++r) p[kb][r] = 0.f;
#pragma unroll
        for (int s = 0; s < 16; ++s) {
            const bf16x8 qf = *(const bf16x8*)(qp + 16 * s); const int c = 2 * s + hi;
#pragma unroll
            for (int kb = 0; kb < 4; ++kb) { const bf16x8 kf = *(const LAS bf16x8*)(lds + (128 * half + 32 * kb + r32) * 512 + ((c ^ r32) << 4)); p[kb] = MFMA32(kf, qf, p[kb]); }
        }
#pragma unroll
        for (int kb = 0; kb < 4; ++kb) {
#pragma unroll
            for (int r = 0; r < 16; ++r) { const float e = __builtin_amdgcn_exp2f(p[kb][r] * rq); l += e; p[kb][r] = e; }
            pa[4 * half + kb][0] = __builtin_bit_cast(bf16x8, PACK8(p[kb], 0)); pa[4 * half + kb][1] = __builtin_bit_cast(bf16x8, PACK8(p[kb], 1));
        }
    }
    l += __shfl_xor(l, 32);
    const float rl = 1.0f / l;
    __syncthreads();
#pragma unroll
    for (int i = 0; i < 16; ++i) { const int pim = w * 16 + i, row = 2 * pim + rip, c = (((pos >> 2) ^ (row & 7)) << 2) | (pos & 3);
        glds16(kvb + 1024 + (size_t)row * 2048 + c * 8, (unsigned)__builtin_amdgcn_readfirstlane((int)(ldsb + pim * 1024))); }
    asm volatile("s_waitcnt vmcnt(0)" ::: "memory");
    __syncthreads();
    const int blk = (lane >> 4) & 1, p4 = lane & 3, q4 = (lane & 15) >> 2;
    bf16* op = O + R * DM + h * 256 + 4 * hi;
#pragma unroll
    for (int dp = 0; dp < 4; ++dp) {
        f32x16 oa[2], ob[2];
#pragma unroll
        for (int e = 0; e < 2; ++e)
#pragma unroll
            for (int r = 0; r < 16; ++r) { oa[e][r] = 0.f; ob[e][r] = 0.f; }
#pragma unroll
        for (int ks = 0; ks < 16; ks += 2) {
            s16x4 lo[2][2], hh[2][2];
#pragma unroll
            for (int kk = 0; kk < 2; ++kk) { const int rowA = 16 * (ks + kk) + 4 * hi + q4, rowB = rowA + 8;
#pragma unroll
                for (int e = 0; e < 2; ++e) { const int d0 = 2 * dp + e;
                    lo[kk][e] = vtr(lds + rowA * 512 + ((d0 ^ (rowA & 7)) << 6) + 32 * blk + 8 * p4);
                    hh[kk][e] = vtr(lds + rowB * 512 + ((d0 ^ (rowB & 7)) << 6) + 32 * blk + 8 * p4); } }
#pragma unroll
            for (int e = 0; e < 2; ++e) {
                oa[e] = MFMA32(__builtin_shufflevector(lo[0][e], hh[0][e], 0, 1, 2, 3, 4, 5, 6, 7), pa[ks >> 1][0], oa[e]);
                ob[e] = MFMA32(__builtin_shufflevector(lo[1][e], hh[1][e], 0, 1, 2, 3, 4, 5, 6, 7), pa[ks >> 1][1], ob[e]);
            }
        }
#pragma unroll
        for (int e = 0; e < 2; ++e)
#pragma unroll
            for (int k = 0; k < 2; ++k) {
                u32x2 wv[2];
#pragma unroll
                for (int gi = 0; gi < 2; ++gi) { const int g = 2 * k + gi;
                    wv[gi].x = cvtpk((oa[e][4 * g] + ob[e][4 * g]) * rl, (oa[e][4 * g + 1] + ob[e][4 * g + 1]) * rl); wv[gi].y = cvtpk((oa[e][4 * g + 2] + ob[e][4 * g + 2]) * rl, (oa[e][4 * g + 3] + ob[e][4 * g + 3]) * rl); }
                *(u32x4*)(op + 32 * (2 * dp + e) + 16 * k + 4 * hi) = widen_pair(wv[0], wv[1]); }
    }
}

#define XB_TMO      128
#define XB_XCNT(j)  (256  + 64 * (j))
#define XB_XSUB(j)  (1280 + 64 * (j))
#define XB_XGEN(j)  (2304 + 64 * (j))
#define XB_TOP      3328
#define XB_TOPGEN   3392
#define XCD_BAR_WORDS 3456
#define XB_SPIN_CAP (1u << 18)

__device__ __forceinline__ unsigned xb_ld(unsigned* p)              { return __hip_atomic_load(p, __ATOMIC_RELAXED, __HIP_MEMORY_SCOPE_AGENT); }
__device__ __forceinline__ unsigned xb_add(unsigned* p, unsigned v) { return __hip_atomic_fetch_add(p, v, __ATOMIC_RELAXED, __HIP_MEMORY_SCOPE_AGENT); }
__device__ __forceinline__ unsigned xb_xcc_id() { return (unsigned)__builtin_amdgcn_s_getreg((3 << 11) | 20) & 0xFu; }
#define XB_SPIN(cond, bar) do { unsigned _sp = 0; while (cond) { __builtin_amdgcn_s_sleep(1); \
    if ((++_sp & 255u) == 0u) { if (xb_ld(&(bar)[XB_TMO])) break; if (_sp > XB_SPIN_CAP) { atomicAdd(&(bar)[XB_TMO], 1u); break; } } } } while (0)

struct XcdBarrier {
    unsigned* bar; unsigned x;
    volatile LAS unsigned* st;
};

__device__ __forceinline__ XcdBarrier xcd_barrier_post(unsigned* bar, volatile LAS unsigned* st) {
    XcdBarrier b; b.bar = bar; b.x = xb_xcc_id(); b.st = st;
    if (threadIdx.x == 0) (void)xb_add(&bar[XB_XCNT(b.x)], 1u);
    return b;
}
__device__ __forceinline__ void xcd_barrier_complete(unsigned* bar, unsigned x, unsigned& nloc, unsigned& nx) {
    const unsigned G = gridDim.x * gridDim.y * gridDim.z;
    unsigned sum, cnt, mine, sp = 0u;
    for (;;) {
        sum = 0u; cnt = 0u; mine = 0u;
#pragma unroll
        for (unsigned j = 0; j < 16; ++j) { const unsigned c = xb_ld(&bar[XB_XCNT(j)]); sum += c; cnt += (c > 0u) ? 1u : 0u; mine = (j == x) ? c : mine; }
        if (sum == G) break;
        __builtin_amdgcn_s_sleep(1);
        if ((++sp & 255u) == 0u) { if (xb_ld(&bar[XB_TMO])) break; if (sp > XB_SPIN_CAP) { atomicAdd(&bar[XB_TMO], 1u); break; } }
    }
    nloc = mine > 0u ? mine : 1u; nx = cnt > 0u ? cnt : 1u;
}

__device__ __forceinline__ void xcd_barrier(const XcdBarrier& b) {
    asm volatile("s_waitcnt vmcnt(0)" ::: "memory");
    __syncthreads();
    if (threadIdx.x == 0) {
        unsigned* bar = b.bar;
        __builtin_amdgcn_s_waitcnt(0);
        unsigned nloc = b.st[0], nx = b.st[1];
        if (nloc == 0u) { xcd_barrier_complete(bar, b.x, nloc, nx); b.st[0] = nloc; b.st[1] = nx; }
        const unsigned old = xb_add(&bar[XB_XSUB(b.x)], 1u);
        const unsigned gen = old / nloc;
        if (old + 1u == (gen + 1u) * nloc) {
            __builtin_amdgcn_fence(__ATOMIC_RELEASE, "agent");
            asm volatile("s_waitcnt vmcnt(0)" ::: "memory");
            const unsigned og = xb_add(&bar[XB_TOP], 1u);
            const unsigned tg = og / nx;
            if (og + 1u == (tg + 1u) * nx) xb_add(&bar[XB_TOPGEN], 1u);
            else XB_SPIN(xb_ld(&bar[XB_TOPGEN]) == tg, bar);
            __builtin_amdgcn_fence(__ATOMIC_ACQUIRE, "agent");
            xb_add(&bar[XB_XGEN(b.x)], 1u);
            asm volatile("s_waitcnt vmcnt(0)" ::: "memory");
        } else {
            XB_SPIN(xb_ld(&bar[XB_XGEN(b.x)]) == gen, bar);
            __builtin_amdgcn_fence(__ATOMIC_ACQUIRE, "agent");
            asm volatile("s_waitcnt vmcnt(0)" ::: "memory");
        }
    }
    __syncthreads();
}

struct Args { const float* in[17]; float* out; unsigned char* ws; };
typedef const __attribute__((address_space(4))) Args* cargs_t;
__device__ __forceinline__ cargs_t get_args() { cargs_t p = (cargs_t)__builtin_amdgcn_kernarg_segment_ptr(); asm volatile("" : "+s"(p)); return p; }
#define PHASE_VARS cargs_t A = get_args(); unsigned char* ws = A->ws; const int tid = tid_opaque(), lane = tid & 63, wave = __builtin_amdgcn_readfirstlane(tid >> 6), G = gridDim.x, bx = blockIdx.x, gw = bx * 8 + wave, NGW = G * 8; (void)lane; (void)gw; (void)NGW; (void)ws
#define P_XB ((bf16*)(ws + WS_XB))
#define P_R1 ((bf16*)(ws + WS_R1))
#define P_O ((bf16*)(ws + WS_O))
#define P_KV ((bf16*)(ws + WS_KV))
#define P_MEMB ((bf16*)(ws + WS_MEMB))
#define P_XSS(slot) ((float*)(ws + WS_XSS) + (size_t)(slot) * T_TOK)
#define P_QPART ((float*)(ws + WS_QPART))
#define P_KPART ((float*)(ws + WS_KPART))
#define P_MSS ((float*)(ws + WS_MSS))
#define P_CTR ((int*)(ws + WS_CTR))
#define P_WL(l) ((const bf16*)(ws + WS_W + (size_t)(l) * W_LAYER))

__global__ void __launch_bounds__(512, 2) hymba_fwd(Args a_unused) {
    extern __shared__ __attribute__((aligned(16))) unsigned char lds_raw[];
    LAS unsigned char* lds = (LAS unsigned char*)lds_raw;
    cg::grid_group grid = cg::this_grid();
    if (threadIdx.x < 8) ((volatile LAS unsigned*)(lds + MISC_OFF + 128))[threadIdx.x] = 0u;
    __syncthreads();
    { cargs_t A0 = get_args(); (void)xcd_barrier_post((unsigned*)(A0->ws + WS_BAR), (volatile LAS unsigned*)(lds + MISC_OFF + 128)); }
    if (gridDim.x == 0x7fffffffu) grid.sync();
#define GRID_SYNC() do { XcdBarrier b_; b_.bar = (unsigned*)(get_args()->ws + WS_BAR); b_.x = xb_xcc_id(); b_.st = (volatile LAS unsigned*)(lds + MISC_OFF + 128); xcd_barrier(b_); } while (0)

    {
        PHASE_VARS;
        LAS float* scr = (LAS float*)(lds + wave * 16384);
        constexpr int I_IN = 32 * (INC / 64), I_SQ = 32 * 16, I_KV = 32 * 32, I_UP = 32 * 64, I_DN = 128 * 16;
        constexpr int PER_LAYER = I_IN + 3 * I_SQ + I_KV + I_UP + I_DN;
        for (int it = gw; it < 2 * PER_LAYER; it += NGW) {
            const int itr = 2 * PER_LAYER - 1 - it;
            const int l = itr / PER_LAYER; int r = itr % PER_LAYER;
            bf16* wl = (bf16*)(ws + WS_W + (size_t)l * W_LAYER);
            if (r < I_IN) { transpose_item(A->in[3] + (size_t)l * DM * INC, DM, INC, wl + WO_IN / 2, A->in[2] + l * DM, true, scr, r, lane); continue; } r -= I_IN;
            if (r < I_SQ) { transpose_item(A->in[6] + (size_t)l * DM * DM, DM, DM, wl + WO_MIX / 2, A->in[5] + l * 512, false, scr, r, lane, 512, 512); continue; } r -= I_SQ;
            if (r < I_SQ) { transpose_item(A->in[9] + (size_t)l * DM * DM, DM, DM, wl + WO_XQ / 2, A->in[7] + l * DM, false, scr, r, lane); continue; } r -= I_SQ;
            if (r < I_KV) { transpose_item(A->in[10] + (size_t)l * DM * 2048, DM, 2048, wl + WO_XKV / 2, A->in[8] + l * DM, false, scr, r, lane); continue; } r -= I_KV;
            if (r < I_SQ) { transpose_item(A->in[13] + (size_t)l * DM * DM, DM, DM, wl + WO_XO / 2, nullptr, false, scr, r, lane); continue; } r -= I_SQ;
            if (r < I_UP) { transpose_item(A->in[15] + (size_t)l * DM * FF, DM, FF, wl + WO_UP / 2, A->in[14] + l * DM, false, scr, r, lane); continue; } r -= I_UP;
            transpose_item(A->in[16] + (size_t)l * FF * DM, FF, DM, wl + WO_DOWN / 2, nullptr, false, scr, r, lane);
        }
        const float* x_in = A->in[0]; const float* mem = A->in[1];
        for (int m = 2 * gw; m < T_TOK; m += 2 * NGW) rows2_to_bf16(x_in + (size_t)m * DM, P_XB + (size_t)m * DM, P_XSS(0) + m, lane);
        for (int m = 2 * gw; m < MROWS; m += 2 * NGW) rows2_to_bf16(mem + (size_t)m * DM, P_MEMB + (size_t)m * DM, P_MSS + m, lane);
        if (bx == 0 && tid < 16) P_CTR[tid] = 0;
    }
    GRID_SYNC();

    for (int l = 0; l < 2; ++l) {
        asm volatile("" : "+s"(l));
        {
            PHASE_VARS;
            pg8::Gemm g{P_XB, P_WL(l) + WO_IN / 2, T_TOK, INC, DM, DM, 1 << 30, 0l, nullptr}; pg8::StaticOrder S; S.init(T_TOK, INC, G, bx);
            pg8::EpiB<pg8::EM_PROJ> E{P_R1, INC, P_XSS(3 * l), nullptr};
            pg8::gemm_phase(lds, g, S, E);
        }
        {
            PHASE_VARS;
            pg8::Gemm g2{P_MEMB, P_WL(l) + WO_XKV / 2, MROWS, 2048, DM, DM, 1 << 30, 0l, nullptr}; pg8::StaticOrder S2; S2.init(MROWS, 2048, G, G - 1 - bx);
            pg8::EpiB<pg8::EM_KV> E2{P_KV, 2048, P_MSS, P_KPART};
            pg8::gemm_phase(lds, g2, S2, E2);
        }
        GRID_SYNC();
        {
            PHASE_VARS;
            const float* gqn = A->in[11] + l * 256; const float* gkn = A->in[12] + l * 256;
            bf16* kv = P_KV; const float* kpart = P_KPART;
            for (int it = gw; it < MROWS * 4; it += NGW) {
                const int row = it >> 2, hh = it & 3;
                const f32x4 kp = *(const f32x4*)(kpart + (size_t)row * 16 + hh * 4);
                const float rk = rsqrtf(((kp[0] + kp[1]) + (kp[2] + kp[3])) * (1.0f / 256.0f) + EPS) * (0.0625f * 1.4426950408889634f);
                u32x2* p = (u32x2*)(kv + (size_t)row * 2048 + hh * 256) + lane;
                const u32x2 v = *p; const f32x4 g1 = *((const f32x4*)gqn + lane), g2 = *((const f32x4*)gkn + lane);
                u32x2 o; o.x = cvtpk(bflo(v.x) * rk * g1[0] * g2[0], bfhi(v.x) * rk * g1[1] * g2[1]); o.y = cvtpk(bflo(v.y) * rk * g1[2] * g2[2], bfhi(v.y) * rk * g1[3] * g2[3]);
                *p = o;
            }
        }
        {
            PHASE_VARS;
            volatile LAS int* misc = (volatile LAS int*)(lds + MISC_OFF);
            const float* gret = A->in[4] + l * 512;
            for (int u = bx; u < 256; u += G) { const int bb = u & 7, idx = u >> 3, hh = idx >> 3, qb = idx & 7; attn_unit<128, false>(lds, P_R1, bb, hh, qb, log2f(1.0f - exp2f(-5.0f - (float)hh)), gret, nullptr); }
            for (;;) {
                if (tid == 0) misc[0] = atomicAdd(P_CTR + l, 1);
                __syncthreads();
                const int u = misc[0];
                __syncthreads();
                if (u >= 512) break;
                const int qb = 7 - (u >> 6), j = u & 63; sb_unit(lds, P_R1, j >> 3, j & 7, qb, P_QPART);
            }
        }
        GRID_SYNC();
        {
            PHASE_VARS;
            pg8::Gemm g{P_R1 + 2048, P_WL(l) + WO_MIX / 2, T_TOK, DM, DM, INC, 8, -5120l, P_QPART}; pg8::StaticOrder S; S.init(T_TOK, DM, G, bx);
            pg8::EpiRes<false> E{nullptr, P_XB, P_XSS(3 * l + 1)};
            if (G >= 256) {
                pg8::Unit u0;
                if (S.next(0, u0) && tid < 256) { const float* hp = P_QPART + (size_t)(u0.pm * 256 + tid) * 8; const f32x4 s0 = *(const f32x4*)hp, s1 = *(const f32x4*)(hp + 4);
                    ((LAS float*)(lds + MISC_OFF + 1024))[tid] = rsqrtf((((s0[0] + s0[1]) + (s0[2] + s0[3])) + ((s1[0] + s1[1]) + (s1[2] + s1[3]))) * (1.0f / 512.0f) + EPS); }
                __syncthreads();
                pg8::gemm_phase<2>(lds, g, S, E);
            } else pg8::gemm_phase<1>(lds, g, S, E);
        }
        GRID_SYNC();
        {
            PHASE_VARS;
            pg8::Gemm g{P_XB, P_WL(l) + WO_XQ / 2, T_TOK, DM, DM, DM, 1 << 30, 0l, nullptr}; pg8::StaticOrder S; S.init(T_TOK, DM, G, bx);
            pg8::EpiB<pg8::EM_Q> E{P_R1, DM, P_XSS(3 * l + 1), P_QPART};
            pg8::gemm_phase(lds, g, S, E);
        }
        {
            PHASE_VARS;
            __syncthreads();
            pg8::StaticOrder S; S.init(T_TOK, DM, G, bx); pg8::Unit u;
            for (int i = 0; S.next(i, u); ++i) xattn_unit(lds, P_R1, P_KV, P_QPART, P_O, u.pm >> 3, u.pn, u.pm & 7);
        }
        GRID_SYNC();
        {
            PHASE_VARS;
            pg8::Gemm g{P_O, P_WL(l) + WO_XO / 2, T_TOK, DM, DM, DM, 1 << 30, 0l, nullptr}; pg8::StaticOrder S; S.init(T_TOK, DM, G, bx);
            pg8::EpiRes<false> E{nullptr, P_XB, P_XSS(3 * l + 2)};
            pg8::gemm_phase(lds, g, S, E);
        }
        GRID_SYNC();
        {
            PHASE_VARS;
            pg8::Gemm g{P_XB, P_WL(l) + WO_UP / 2, T_TOK, FF, DM, DM, 1 << 30, 0l, nullptr}; pg8::StaticOrder S; S.init(T_TOK, FF, G, bx);
            g.pub = (int*)(ws + WS_PUB) + l * 4096;
            pg8::EpiB<pg8::EM_UP> E{P_R1, FF, P_XSS(3 * l + 2), nullptr};
            pg8::gemm_phase<false, true>(lds, g, S, E);
        }
        {
            PHASE_VARS;
            {
                pg8::StaticOrder Sw; Sw.init(T_TOK, DM, G, bx); pg8::Unit uw;
                if (wave == 0) {
                    int* pub = (int*)(ws + WS_PUB) + l * 4096;
                    for (int i = 0; Sw.next(i, uw); ++i) {
                        unsigned spins = 0;
                        while (__builtin_amdgcn_readfirstlane(__hip_atomic_load(pub + 64 * uw.pm, __ATOMIC_RELAXED, __HIP_MEMORY_SCOPE_AGENT)) < 128) { __builtin_amdgcn_s_sleep(2); if (++spins > (1u << 22)) break; }
                    }
                    __builtin_amdgcn_fence(__ATOMIC_ACQUIRE, "agent");
                    asm volatile("s_waitcnt vmcnt(0)" ::: "memory");
                }
                __syncthreads();
            }
            pg8::Gemm g{P_R1, P_WL(l) + WO_DOWN / 2, T_TOK, DM, FF, FF, 1 << 30, 0l, nullptr}; pg8::StaticOrder S; S.init(T_TOK, DM, G, bx);
            if (l == 1) { pg8::EpiRes<true> E{A->out, P_XB, nullptr}; pg8::gemm_phase(lds, g, S, E); }
            else { pg8::EpiRes<false> E{nullptr, P_XB, P_XSS(3 * l + 3)}; pg8::gemm_phase(lds, g, S, E); }
        }
        if (l == 0) GRID_SYNC();
    }
}

extern "C" void kernel_launch(void* const* d_in, const int* in_sizes, int n_in, void* d_out, int out_size, void* d_ws, size_t ws_size, hipStream_t stream) {
    static int grid = 0;
    if (grid == 0) {
        if (n_in != 17 || ws_size < WS_END) { fprintf(stderr, "kernel_launch: unexpected n_in %d / ws_size %zu\n", n_in, ws_size); grid = -1; return; }
        int dev = 0, cus = 0, per_cu = 0;
        hipGetDevice(&dev);
        hipDeviceGetAttribute(&cus, hipDeviceAttributeMultiprocessorCount, dev);
        hipFuncSetAttribute((const void*)hymba_fwd, hipFuncAttributeMaxDynamicSharedMemorySize, LDS_BYTES);
        hipOccupancyMaxActiveBlocksPerMultiprocessor(&per_cu, (const void*)hymba_fwd, 512, LDS_BYTES);
        if (per_cu < 1) { fprintf(stderr, "kernel_launch: occupancy query reports %d blocks per CU\n", per_cu); per_cu = 1; }
        grid = cus;
    }
    if (grid < 0) return;
    if (hipMemsetAsync((char*)d_ws + WS_CTR, 0, WS_CTL_BYTES, stream) != hipSuccess) { fprintf(stderr, "kernel_launch: memset of control words failed\n"); return; }
    Args a{};
    for (int i = 0; i < 17; ++i) a.in[i] = (const float*)d_in[i];
    a.out = (float*)d_out; a.ws = (unsigned char*)d_ws;
    void* args[] = {&a};
    hipError_t e = hipLaunchCooperativeKernel((const void*)hymba_fwd, dim3(grid), dim3(512), args, LDS_BYTES, stream);
    if (e != hipSuccess) fprintf(stderr, "cooperative launch failed: %s (grid %d)\n", hipGetErrorString(e), grid);
}
```

```cpp
#include <hip/hip_runtime.h>
#include <hip/hip_cooperative_groups.h>
#include <cstdio>
#include <cstdint>
namespace cg = cooperative_groups;

#define LAS __attribute__((address_space(3)))
typedef unsigned short bf16;
typedef short bf16x8 __attribute__((ext_vector_type(8)));
typedef short s16x4 __attribute__((ext_vector_type(4)));
typedef float f32x2 __attribute__((ext_vector_type(2)));
typedef float f32x4 __attribute__((ext_vector_type(4)));
typedef float f32x16 __attribute__((ext_vector_type(16)));
typedef unsigned u32x2 __attribute__((ext_vector_type(2)));
typedef unsigned u32x4 __attribute__((ext_vector_type(4)));
typedef __bf16 bf16x2_t __attribute__((ext_vector_type(2)));

constexpr int T_TOK = 16384, DM = 1024, SEQ = 2048, NB = 8, NMEM = 256, MROWS = NB * NMEM, INC = 3584, FF = 4096;
constexpr float EPS = 1e-6f;
constexpr size_t MiB = 1u << 20;
constexpr size_t WS_W = 0, W_LAYER = 33 * MiB;
constexpr size_t WO_IN = 0, WO_MIX = 3584ull * 2048, WO_XQ = 4608ull * 2048, WO_XKV = 5632ull * 2048, WO_XO = 7680ull * 2048, WO_UP = 8704ull * 2048, WO_DOWN = 12800ull * 2048;
constexpr size_t WS_XB = 66 * MiB;
constexpr size_t WS_R1 = 98 * MiB;
constexpr size_t WS_O = WS_R1 + 32 * MiB;
constexpr size_t WS_KV = 226 * MiB;
constexpr size_t WS_MEMB = 234 * MiB;
constexpr size_t WS_XPART = 238 * MiB;
constexpr size_t WS_QPART = 239 * MiB;
constexpr size_t WS_KPART = 240 * MiB;
constexpr size_t WS_MPART = WS_KPART + 256 * 1024;
constexpr size_t WS_CTR = 241 * MiB;
constexpr size_t WS_PUB = WS_CTR + 32768;
constexpr size_t WS_BAR = WS_CTR + 4096;
constexpr size_t WS_XSS = WS_CTR + 65536;
constexpr size_t WS_MSS = WS_XSS + 7 * 65536;
constexpr size_t WS_CTL_BYTES = 65536 + 7 * 65536 + 8192;
constexpr size_t WS_END = 242 * MiB;
constexpr int LDS_BYTES = 147456, MISC_OFF = 131072;

__device__ __forceinline__ unsigned cvtpk(float lo, float hi) { f32x2 v = {lo, hi}; bf16x2_t b = __builtin_convertvector(v, bf16x2_t); return __builtin_bit_cast(unsigned, b); }
__device__ __forceinline__ float bf2f(unsigned short h) { return __uint_as_float(((unsigned)h) << 16); }
__device__ __forceinline__ float bflo(unsigned w) { return __uint_as_float(w << 16); }
__device__ __forceinline__ float bfhi(unsigned w) { return __uint_as_float(w & 0xffff0000u); }
__device__ __forceinline__ int tid_opaque() { int t = threadIdx.x; asm volatile("" : "+v"(t)); return t; }
__device__ __forceinline__ int crow(int r, int hi) { return (r & 3) + 8 * (r >> 2) + 4 * hi; }
__device__ __forceinline__ float wave_sum(float v) {
#pragma unroll
    for (int o = 1; o < 64; o <<= 1) v += __shfl_xor(v, o);
    return v;
}

template <int OFF> __device__ __forceinline__ void store16_wt(void* p, u32x4 v) { asm volatile("global_store_dwordx4 %0, %1, off offset:%2 sc1\n\ts_nop 1" :: "v"(p), "v"(v), "n"(OFF) : "memory"); }

namespace pg8 {
constexpr int BM = 256, BK = 64, HALF = 128, HTB = HALF * BK * 2, STAGE_BYTES = 8 * HTB, NXCD = 8, WGM = 8;
__host__ __device__ __forceinline__ int lds_byte(int r, int c) { const int st = (r >> 4) * 2 + (c >> 5), rr = r & 15, cc = c & 31, ob = rr * 64 + cc * 2; return st * 1024 + (ob ^ (((ob >> 9) & 1) << 5)); }
__host__ __device__ __forceinline__ void stage_rc(int b, int& R, int& C) { const int st = b / 1024, sb = b % 1024, swz = sb ^ (((sb >> 9) & 1) << 5); R = (st >> 1) * 16 + swz / 64; C = (st & 1) * 32 + (swz % 64) / 2; }
__host__ __device__ __forceinline__ int perm32(int rho) { const int n = rho >> 4, i = rho & 15; return 8 * (i >> 2) + 4 * n + (i & 3); }

struct Unit { int pm, pn; };
struct Gemm { const bf16* A; const bf16* Bt; int M, N, K, lda; int tj; long ajump; const float* hpart; int* pub = nullptr; };

struct StaticOrder {
    int nM, nN, nwg, G, c;
    __host__ __device__ void init(int M, int N, int G_, int c_) { nM = M / BM; nN = N / BM; nwg = nM * nN; G = G_; c = c_; }
    __host__ __device__ bool next(int i, Unit& u) const {
        const long L = (long)i * G + c; if (L >= nwg) return false;
        int wgid = (int)L; { const int q = nwg / NXCD, r = nwg % NXCD, xcd = wgid % NXCD, off = wgid / NXCD; wgid = (xcd < r ? xcd * (q + 1) : r * (q + 1) + (xcd - r) * q) + off; }
        const int nig = WGM * nN, gid = wgid / nig, fm = gid * WGM, gsz = (nM - fm) < WGM ? (nM - fm) : WGM;
        u.pm = fm + ((wgid % nig) % gsz); u.pn = (wgid % nig) / gsz; return true;
    }
};

enum { EM_PROJ = 0, EM_Q = 1, EM_UP = 2, EM_KV = 3 };
template <int MODE> struct EpiB {
    static constexpr bool PERM = true;
    bf16* O; int ldc; const float* part; float* opart;
    __device__ __forceinline__ void operator()(const f32x4 (&acc)[2][2][4][2], const Unit& u, int wr, int wc, int fr, int fq) const {
        const int row0 = u.pm * BM + wr * 64 + fr;
        const int colL = wc * 32 + 8 * fq;
        const int tt = u.pn >> 1;
        float inv[4];
        if (MODE == EM_PROJ) {
#pragma unroll
            for (int e = 0; e < 4; ++e) inv[e] = __builtin_amdgcn_exp2f(-(float)(16 * wc + 4 * fq + e) * (13.287712379549449f / 63.0f)) * 0.15915494309189535f;
        }
        float ssr[2][4];
#pragma unroll
        for (int ai = 0; ai < 2; ++ai)
#pragma unroll
            for (int m = 0; m < 4; ++m) ssr[ai][m] = part[row0 + ai * HALF + m * 16];
#pragma unroll
        for (int ai = 0; ai < 2; ++ai)
#pragma unroll
            for (int m = 0; m < 4; ++m) {
                const int row = row0 + ai * HALF + m * 16;
                const float rstd = rsqrtf(ssr[ai][m] * (1.0f / 1024.0f) + EPS);
                float sn[4], cs[4];
                if (MODE == EM_PROJ && tt <= 1) {
                    const float pos = (float)(row & (SEQ - 1));
#pragma unroll
                    for (int e = 0; e < 4; ++e) { const float rev = __builtin_amdgcn_fractf(pos * inv[e]); sn[e] = __builtin_amdgcn_sinf(rev); cs[e] = __builtin_amdgcn_cosf(rev); }
                }
                float sq = 0.f;
                bf16* rowp = O + (size_t)row * ldc + u.pn * BM + colL;
#pragma unroll
                for (int bj = 0; bj < 2; ++bj) {
                    f32x4 v0 = acc[ai][bj][m][0] * rstd, v1 = acc[ai][bj][m][1] * rstd;
                    if (MODE == EM_PROJ) {
                        if (tt <= 1) {
                            const float sc = (tt == 1) ? 0.08838834764831845f : 1.0f;
                            f32x4 a0, a1;
                            a0[0] = (v0[0] * cs[0] - v0[1] * sn[0]) * sc; a0[1] = (v0[0] * sn[0] + v0[1] * cs[0]) * sc;
                            a0[2] = (v0[2] * cs[1] - v0[3] * sn[1]) * sc; a0[3] = (v0[2] * sn[1] + v0[3] * cs[1]) * sc;
                            a1[0] = (v1[0] * cs[2] - v1[1] * sn[2]) * sc; a1[1] = (v1[0] * sn[2] + v1[1] * cs[2]) * sc;
                            a1[2] = (v1[2] * cs[3] - v1[3] * sn[3]) * sc; a1[3] = (v1[2] * sn[3] + v1[3] * cs[3]) * sc;
                            v0 = a0; v1 = a1;
                        } else if (tt == 3) {
#pragma unroll
                            for (int j = 0; j < 4; ++j) { v0[j] = v0[j] * __builtin_amdgcn_rcpf(1.0f + __builtin_amdgcn_exp2f(-1.4426950408889634f * v0[j])); v1[j] = v1[j] * __builtin_amdgcn_rcpf(1.0f + __builtin_amdgcn_exp2f(-1.4426950408889634f * v1[j])); }
                        } else if (tt == 4) { v0 = v0 * 0.18033688011112042f; v1 = v1 * 0.18033688011112042f; }
                    } else if (MODE == EM_UP) {
#pragma unroll
                        for (int j = 0; j < 4; ++j) { const float a = fmaxf(v0[j], 0.f), b = fmaxf(v1[j], 0.f); v0[j] = a * a; v1[j] = b * b; }
                    } else {
                        sq += (v0[0] * v0[0] + v0[1] * v0[1]) + (v0[2] * v0[2] + v0[3] * v0[3]) + (v1[0] * v1[0] + v1[1] * v1[1]) + (v1[2] * v1[2] + v1[3] * v1[3]);
                    }
                    u32x4 w; w.x = cvtpk(v0[0], v0[1]); w.y = cvtpk(v0[2], v0[3]); w.z = cvtpk(v1[0], v1[1]); w.w = cvtpk(v1[2], v1[3]);
                    if (bj == 0) store16_wt<0>(rowp, w); else store16_wt<HALF * 2>(rowp, w);
                }
                if (MODE == EM_Q || MODE == EM_KV) {
                    sq += __shfl_xor(sq, 16); sq += __shfl_xor(sq, 32);
                    if (fq == 0 && (MODE == EM_Q || u.pn < 4)) opart[(size_t)row * 16 + u.pn * 4 + wc] = sq;
                }
            }
    }
};
template <bool OUT_F32> struct EpiRes {
    static constexpr bool PERM = true;
    float* xout; bf16* xb; float* opart;
    __device__ __forceinline__ void operator()(const f32x4 (&acc)[2][2][4][2], const Unit& u, int wr, int wc, int fr, int fq) const {
        const int row0 = u.pm * BM + wr * 64 + fr, col0 = u.pn * BM + wc * 32 + 8 * fq;
        u32x4 xws[2][4][2];
#pragma unroll
        for (int ai = 0; ai < 2; ++ai)
#pragma unroll
            for (int m = 0; m < 4; ++m)
#pragma unroll
                for (int bj = 0; bj < 2; ++bj) xws[ai][m][bj] = *(const u32x4*)(xb + (size_t)(row0 + ai * HALF + m * 16) * DM + col0 + bj * HALF);
#pragma unroll
        for (int ai = 0; ai < 2; ++ai)
#pragma unroll
            for (int m = 0; m < 4; ++m) {
                const int row = row0 + ai * HALF + m * 16; const size_t off = (size_t)row * DM + col0; float sq = 0.f;
#pragma unroll
                for (int bj = 0; bj < 2; ++bj) {
                    const u32x4 xw = xws[ai][m][bj];
                    const f32x4 o0 = (f32x4){bflo(xw.x), bfhi(xw.x), bflo(xw.y), bfhi(xw.y)} + acc[ai][bj][m][0];
                    const f32x4 o1 = (f32x4){bflo(xw.z), bfhi(xw.z), bflo(xw.w), bfhi(xw.w)} + acc[ai][bj][m][1];
                    if (OUT_F32) { __builtin_nontemporal_store(o0, (f32x4*)(xout + off + bj * HALF)); __builtin_nontemporal_store(o1, (f32x4*)(xout + off + bj * HALF + 4)); }
                    u32x4 w; w.x = cvtpk(o0[0], o0[1]); w.y = cvtpk(o0[2], o0[3]); w.z = cvtpk(o1[0], o1[1]); w.w = cvtpk(o1[2], o1[3]);
                    if (bj == 0) store16_wt<0>(xb + off, w); else store16_wt<HALF * 2>(xb + off, w);
                    sq += ((o0[0] * o0[0] + o0[1] * o0[1]) + (o0[2] * o0[2] + o0[3] * o0[3])) + ((o1[0] * o1[0] + o1[1] * o1[1]) + (o1[2] * o1[2] + o1[3] * o1[3]));
                }
                sq += __shfl_xor(sq, 16); sq += __shfl_xor(sq, 32);
                if (fq == 0 && opart) unsafeAtomicAdd(opart + row, sq);
            }
    }
};

template <int HOOK = 0, bool PUB = false, class Epi, class Sched, bool ALIGN_EPI = true>
__device__ __forceinline__ void gemm_phase(LAS unsigned char* lds, const Gemm g, const Sched& S, const Epi& E) {
    const int tid = tid_opaque(), wid = __builtin_amdgcn_readfirstlane(tid >> 6), lane = tid & 63, wr = wid >> 2, wc = wid & 3, fr = lane & 15, fq = lane >> 4;
    const int K = g.K, nt = K / BK, lda = g.lda, tj = g.tj; const long ajump = g.ajump;
#define PG8_AO(tt) ((long)(tt) * (long)kstep + ((tt) >= tj ? ajump : 0l))
    unsigned voffA[2], voffB[2];
#pragma unroll
    for (int i = 0; i < 2; ++i) { int R, C; stage_rc(tid * 16 + i * 8192, R, C); const int Rb = Epi::PERM ? ((R & ~31) + perm32(R & 31)) : R;
        voffA[i] = (unsigned)(R * lda + C) * 2u; voffB[i] = (unsigned)(Rb * K + C) * 2u; }
    const size_t kstep = (size_t)(BK * 2);
    const size_t hstepA = (size_t)HALF * lda * 2, hstepB = (size_t)HALF * K * 2;
    const size_t tstepA = 2 * hstepA, tstepB = 2 * hstepB;
    const unsigned ldsw = (unsigned)wid * 1024u;
    const int aoff = lds_byte(wr * 64 + fr, fq * 8), boff = lds_byte(wc * 32 + fr, fq * 8);
#define PG8_SA(b, h) (((b) * 2 + (h)) * HTB)
#define PG8_SB(b, h) ((4 + (b) * 2 + (h)) * HTB)
#define PG8_STAGE(bufoff, gbase, voff) do { _Pragma("unroll") for (int _i = 0; _i < 2; ++_i) \
        __builtin_amdgcn_global_load_lds((const unsigned*)((const char*)(gbase) + (voff)[_i]), (LAS unsigned*)(lds + (bufoff) + ldsw + _i * 8192), 16, 0, 0); } while (0)
#define PG8_LDA(dst, b, h) do { _Pragma("unroll") for (int m = 0; m < 4; ++m) _Pragma("unroll") for (int k = 0; k < 2; ++k) dst[m][k] = *(const LAS bf16x8*)(lds + PG8_SA(b, h) + aoff + m * 2048 + k * 1024); } while (0)
#define PG8_LDB(dst, b, h) do { _Pragma("unroll") for (int n = 0; n < 2; ++n) _Pragma("unroll") for (int k = 0; k < 2; ++k) dst[n][k] = *(const LAS bf16x8*)(lds + PG8_SB(b, h) + boff + n * 2048 + k * 1024); } while (0)
#define PG8_MMA(ai, bj, At, Bt) do { __builtin_amdgcn_s_setprio(1); _Pragma("unroll") for (int m = 0; m < 4; ++m) _Pragma("unroll") for (int n = 0; n < 2; ++n) _Pragma("unroll") for (int k = 0; k < 2; ++k) \
        acc[ai][bj][m][n] = __builtin_amdgcn_mfma_f32_16x16x32_bf16(Bt[n][k], At[m][k], acc[ai][bj][m][n], 0, 0, 0); __builtin_amdgcn_s_setprio(0); } while (0)
#define PG8_WAIT_V(n) asm volatile("s_waitcnt vmcnt(" #n ")" ::: "memory")
#define PG8_WAIT_L(n) asm volatile("s_waitcnt lgkmcnt(" #n ")" ::: "memory")
#define PG8_BAR __builtin_amdgcn_s_barrier()
#define PG8_SCHED __builtin_amdgcn_sched_barrier(0)
    Unit cur, nxt; int ui = 0; int prev_pm = 0; (void)prev_pm;
    if (!S.next(0, cur)) return;
    f32x4 acc[2][2][4][2];
#pragma unroll
    for (int a = 0; a < 2; ++a)
#pragma unroll
        for (int b = 0; b < 2; ++b)
#pragma unroll
            for (int m = 0; m < 4; ++m)
#pragma unroll
                for (int n = 0; n < 2; ++n) acc[a][b][m][n] = (f32x4){0.f, 0.f, 0.f, 0.f};
    bf16x8 At[4][2], B0[2][2], B1[2][2];
    const char* cA = (const char*)g.A + (size_t)cur.pm * tstepA; const char* cB = (const char*)g.Bt + (size_t)cur.pn * tstepB;
    PG8_STAGE(PG8_SB(0, 0), cB, voffB); PG8_STAGE(PG8_SB(0, 1), cB + hstepB, voffB); PG8_STAGE(PG8_SA(0, 0), cA, voffA); PG8_STAGE(PG8_SA(0, 1), cA + hstepA, voffA);
    if (wr == 1) PG8_BAR;
    PG8_WAIT_V(2); PG8_BAR;
    PG8_STAGE(PG8_SB(1, 0), cB + kstep, voffB); PG8_STAGE(PG8_SA(1, 0), cA + kstep, voffA); PG8_STAGE(PG8_SB(1, 1), cB + hstepB + kstep, voffB);
    PG8_WAIT_V(6); PG8_BAR;
    for (;;) {
        const bool has_next = S.next(ui + 1, nxt);
        const char* nA = has_next ? (const char*)g.A + (size_t)nxt.pm * tstepA : cA; const char* nB = has_next ? (const char*)g.Bt + (size_t)nxt.pn * tstepB : cB;
        for (int t = 0; t < nt; t += 2) {
            const bool last = (t == nt - 2);
            const char* a1 = cA + PG8_AO(t + 1);
            const char* a2 = last ? nA : cA + PG8_AO(t + 2); const char* b2 = last ? nB : cB + (size_t)(t + 2) * kstep;
            const char* a3 = last ? nA + kstep : cA + PG8_AO(t + 3); const char* b3 = b2 + kstep;
            if constexpr (HOOK != 0) {
                if (t == tj) {
                    int fro = fr; asm volatile("" : "+v"(fro));
#pragma unroll
                    for (int ai = 0; ai < 2; ++ai)
#pragma unroll
                        for (int m = 0; m < 4; ++m) {
                            float rs;
                            if constexpr (HOOK == 2) rs = ((const LAS float*)(lds + MISC_OFF + 1024))[ai * HALF + wr * 64 + m * 16 + fro];
                            else { const int row = cur.pm * BM + ai * HALF + wr * 64 + m * 16 + fro;
                                const f32x4 s0 = *(const f32x4*)(g.hpart + (size_t)row * 8), s1 = *(const f32x4*)(g.hpart + (size_t)row * 8 + 4);
                                rs = rsqrtf((((s0[0] + s0[1]) + (s0[2] + s0[3])) + ((s1[0] + s1[1]) + (s1[2] + s1[3]))) * (1.0f / 512.0f) + EPS); }
#pragma unroll
                            for (int bj = 0; bj < 2; ++bj)
#pragma unroll
                                for (int n = 0; n < 2; ++n) acc[ai][bj][m][n] = acc[ai][bj][m][n] * rs;
                        }
                }
            }
            PG8_LDB(B0, 0, 0); PG8_LDB(B1, 0, 1); PG8_SCHED; PG8_LDA(At, 0, 0); PG8_STAGE(PG8_SA(1, 1), a1 + hstepA, voffA);
            PG8_WAIT_V(8); PG8_WAIT_L(0); PG8_BAR; PG8_MMA(0, 0, At, B0); PG8_MMA(0, 1, At, B1); PG8_BAR; PG8_SCHED;
            PG8_LDA(At, 0, 1); PG8_STAGE(PG8_SB(0, 0), b2, voffB); PG8_STAGE(PG8_SB(0, 1), b2 + hstepB, voffB); PG8_STAGE(PG8_SA(0, 0), a2, voffA);
            PG8_WAIT_V(8); PG8_WAIT_L(0); PG8_BAR; PG8_MMA(1, 0, At, B0); PG8_MMA(1, 1, At, B1); PG8_BAR; PG8_SCHED;
            PG8_LDB(B0, 1, 0); PG8_LDB(B1, 1, 1); PG8_SCHED; PG8_LDA(At, 1, 0); PG8_STAGE(PG8_SA(0, 1), a2 + hstepA, voffA);
            PG8_WAIT_V(8); PG8_WAIT_L(0); PG8_BAR; PG8_MMA(0, 0, At, B0); PG8_MMA(0, 1, At, B1); PG8_BAR; PG8_SCHED;
            PG8_LDA(At, 1, 1); PG8_STAGE(PG8_SB(1, 0), b3, voffB); PG8_STAGE(PG8_SB(1, 1), b3 + hstepB, voffB); PG8_STAGE(PG8_SA(1, 0), a3, voffA);
            PG8_WAIT_V(8); PG8_WAIT_L(0); PG8_BAR; PG8_MMA(1, 0, At, B0); PG8_MMA(1, 1, At, B1); PG8_BAR; PG8_SCHED;
        }
        if constexpr (ALIGN_EPI) { if (wr == 0) PG8_BAR; }
        E(acc, cur, wr, wc, fr, fq);
        if (!has_next) break;
#pragma unroll
        for (int a = 0; a < 2; ++a)
#pragma unroll
            for (int b = 0; b < 2; ++b)
#pragma unroll
                for (int m = 0; m < 4; ++m)
#pragma unroll
                    for (int n = 0; n < 2; ++n) acc[a][b][m][n] = (f32x4){0.f, 0.f, 0.f, 0.f};
        cur = nxt; cA = nA; cB = nB; ++ui;
        if constexpr (ALIGN_EPI) { if (wr == 1) PG8_BAR; }
    }
    PG8_WAIT_V(0);
    if constexpr (PUB) {
        Unit up; for (int i = 0; S.next(i, up); ++i) if (lane == 0) __hip_atomic_fetch_add(g.pub + 64 * up.pm, 1, __ATOMIC_RELAXED, __HIP_MEMORY_SCOPE_AGENT);
    }
    if constexpr (!ALIGN_EPI) { if (wr == 0) PG8_BAR; }
    PG8_BAR;
#undef PG8_AO
#undef PG8_SA
#undef PG8_SB
#undef PG8_STAGE
#undef PG8_LDA
#undef PG8_LDB
#undef PG8_MMA
#undef PG8_WAIT_V
#undef PG8_WAIT_L
#undef PG8_BAR
#undef PG8_SCHED
}
}

__device__ __forceinline__ void transpose_item(const float* W, int K, int N, bf16* WT, const float* g, bool permq, LAS float* scr, int item, int lane, int gk0 = 0, int krot = 0) {
    const int nblk = N / 64, kb = item / nblk, nb = item % nblk, k0 = 32 * kb, n0 = 64 * nb;
    const int kr = lane >> 4, nc = (lane & 15) * 4;
    f32x4 v[8];
#pragma unroll
    for (int i = 0; i < 8; ++i) v[i] = __builtin_nontemporal_load((const f32x4*)(W + (size_t)(k0 + 4 * i + kr) * N + n0 + nc));
    if (g && k0 >= gk0) {
#pragma unroll
        for (int i = 0; i < 8; ++i) v[i] = v[i] * g[k0 - gk0 + 4 * i + kr];
    }
#pragma unroll
    for (int i = 0; i < 8; ++i) { LAS float* d = scr + (4 * i + kr) * 66 + nc; *(LAS f32x2*)d = (f32x2){v[i][0], v[i][1]}; *(LAS f32x2*)(d + 2) = (f32x2){v[i][2], v[i][3]}; }
    asm volatile("s_waitcnt lgkmcnt(0)" ::: "memory");
    const int c = lane >> 4;
#pragma unroll
    for (int j = 0; j < 4; ++j) { const int n = (lane & 15) + 16 * j; const LAS float* s = scr + (8 * c) * 66 + n;
        u32x4 o; o.x = cvtpk(s[0 * 66], s[1 * 66]); o.y = cvtpk(s[2 * 66], s[3 * 66]); o.z = cvtpk(s[4 * 66], s[5 * 66]); o.w = cvtpk(s[6 * 66], s[7 * 66]);
        int nn = n0 + n;
        if (permq && nn < 1024) { const int hd = nn >> 7, i = nn & 127; nn = hd * 128 + (i < 64 ? 2 * i : 2 * (i - 64) + 1); }
        *(u32x4*)(WT + (size_t)nn * K + ((k0 + krot) & (K - 1)) + 8 * c) = o; }
    asm volatile("s_waitcnt lgkmcnt(0)" ::: "memory");
}
__device__ __forceinline__ void rows2_to_bf16(const float* xrow, bf16* orow, float* prow, int lane) {
    const f32x4* xr = (const f32x4*)xrow + lane;
    f32x4 v[8]; float s0 = 0.f, s1 = 0.f;
#pragma unroll
    for (int j = 0; j < 8; ++j) v[j] = __builtin_nontemporal_load(xr + 64 * j);
#pragma unroll
    for (int j = 0; j < 4; ++j) { s0 += (v[j][0] * v[j][0] + v[j][1] * v[j][1]) + (v[j][2] * v[j][2] + v[j][3] * v[j][3]); s1 += (v[j + 4][0] * v[j + 4][0] + v[j + 4][1] * v[j + 4][1]) + (v[j + 4][2] * v[j + 4][2] + v[j + 4][3] * v[j + 4][3]); }
#pragma unroll
    for (int o = 1; o < 64; o <<= 1) { s0 += __shfl_xor(s0, o); s1 += __shfl_xor(s1, o); }
    u32x2* o8 = (u32x2*)orow + lane;
#pragma unroll
    for (int j = 0; j < 8; ++j) { u32x2 w; w.x = cvtpk(v[j][0], v[j][1]); w.y = cvtpk(v[j][2], v[j][3]); o8[64 * j] = w; }
    if (lane < 2) prow[lane] = (lane == 0) ? s0 : s1;
}

#define MFMA32(a, b, c) __builtin_amdgcn_mfma_f32_32x32x16_bf16((a), (b), (c), 0, 0, 0)
typedef short v4i16_t __attribute__((ext_vector_type(4)));
__device__ __forceinline__ s16x4 vtr(const LAS unsigned char* p) { return __builtin_bit_cast(s16x4, __builtin_amdgcn_ds_read_tr16_b64_v4i16((LAS v4i16_t*)p)); }
#define PACK8(x, s) ((u32x4){cvtpk((x)[8 * (s)], (x)[8 * (s) + 1]), cvtpk((x)[8 * (s) + 2], (x)[8 * (s) + 3]), cvtpk((x)[8 * (s) + 4], (x)[8 * (s) + 5]), cvtpk((x)[8 * (s) + 6], (x)[8 * (s) + 7])})

template <bool MASK>
__device__ __forceinline__ void sb_block(f32x16& X, int kb, int t, int hi, float& carry) {
    float e[16], m[16];
#pragma unroll
    for (int r = 0; r < 16; ++r) {
        e[r] = __builtin_amdgcn_exp2f(fminf(X[r], 80.0f));
        m[r] = __builtin_amdgcn_rcpf(1.0f + e[r]);
        if (MASK) { if (!(kb + crow(r, hi) < t)) { m[r] = 1.0f; e[r] = 0.f; } }
    }
    float b[4], ob[4];
#pragma unroll
    for (int g = 0; g < 4; ++g) { b[g] = (m[4 * g] * m[4 * g + 1]) * (m[4 * g + 2] * m[4 * g + 3]); ob[g] = __shfl_xor(b[g], 32); }
    float run = carry;
#pragma unroll
    for (int g = 3; g >= 0; --g) {
        const float suf = (hi == 0) ? run * ob[g] : run;
        const float c3 = m[4 * g + 3] * suf, c2 = m[4 * g + 2] * c3, c1 = m[4 * g + 1] * c2, c0 = m[4 * g] * c1;
        X[4 * g + 3] = e[4 * g + 3] * c3; X[4 * g + 2] = e[4 * g + 2] * c2; X[4 * g + 1] = e[4 * g + 1] * c1; X[4 * g] = e[4 * g] * c0;
        run *= b[g] * ob[g];
    }
    carry = run;
}
__device__ __forceinline__ void ret_block(f32x16& X, int kb, int t, int hi, float lg2) {
#pragma unroll
    for (int r = 0; r < 16; ++r) { const float d = fabsf((float)(t - (kb + crow(r, hi)))); X[r] *= __builtin_amdgcn_exp2f(lg2 * d); }
}
__device__ __forceinline__ void ret_block_f(f32x16& X, float f, float g1, float g8) {
    float fj = f;
#pragma unroll
    for (int j = 0; j < 4; ++j) { float fi = fj;
#pragma unroll
        for (int i = 0; i < 4; ++i) { X[4 * j + i] *= fi; fi *= g1; }
        fj *= g8; }
}

__device__ __forceinline__ u32x4 widen_pair(u32x2 a, u32x2 b) {
    const auto s0 = __builtin_amdgcn_permlane32_swap(a.x, b.x, false, false);
    const auto s1 = __builtin_amdgcn_permlane32_swap(a.y, b.y, false, false);
    return (u32x4){s0[0], s1[0], s0[1], s1[1]};
}
__device__ __forceinline__ void glds16(const void* gsrc, unsigned lds_dst) { unsigned keep;
    asm volatile("s_mov_b32 %0, m0\n\ts_mov_b32 m0, %2\n\ts_nop 0\n\tglobal_load_lds_dwordx4 %1, off\n\ts_mov_b32 m0, %0" : "=&s"(keep) : "v"(gsrc), "s"(lds_dst) : "memory"); }

template <int HD, bool SB>
__device__ __forceinline__ void attn_unit(LAS unsigned char* lds, bf16* P, int b, int h, int qb, float lg2, const float* gret, float* sbpart) {
    constexpr int PITCH = INC, NS = HD / 16, ND = HD / 32, RB = HD * 2, NC = HD / 8, NC64 = HD / 32, KBYTES = 64 * RB;
    const int tid = tid_opaque(), lane = tid & 63, w = __builtin_amdgcn_readfirstlane(tid >> 6), r32 = lane & 31, hi = lane >> 5;
    const int qcol = SB ? 2048 + h * 64 : h * 128, kcol = SB ? 2560 + h * 64 : 512 + h * 128, vcol = SB ? 3072 + h * 64 : 1024 + h * 128;
    const size_t rowbase = (size_t)b * SEQ;
    const int q0 = qb * 256, tq = q0 + 32 * w + r32, wlo = q0 + 32 * w;
    bf16x8 qf[NS];
    { const bf16* qp = P + (rowbase + tq) * PITCH + qcol + hi * 8;
#pragma unroll
      for (int s = 0; s < NS; ++s) qf[s] = *(const bf16x8*)(qp + 16 * s); }
#pragma unroll
    for (int s = 0; s < NS; ++s) asm volatile("" : "+v"(qf[s]));
    f32x16 o[ND];
#pragma unroll
    for (int d = 0; d < ND; ++d)
#pragma unroll
        for (int r = 0; r < 16; ++r) o[d][r] = 0.f;
    float carry = SB ? 1.0f : 0.f;
    float g1 = 1.f, g8 = 1.f, c32 = 1.f;
    if (!SB) { g1 = __builtin_amdgcn_exp2f(-lg2); g8 = __builtin_amdgcn_exp2f(-8.0f * lg2); c32 = __builtin_amdgcn_exp2f(-32.0f * lg2); }
    const int NT = 4 * (qb + 1);
    constexpr int TILEB = 2 * KBYTES, PIECES = TILEB / 1024, PPW = PIECES / 8, RPP = 1024 / RB;
    const int rip = lane / NC, pos = lane % NC;
    const unsigned lds0 = (unsigned)(uintptr_t)lds;
#define AT_DMA(kt, slot) do { _Pragma("unroll") for (int i_ = 0; i_ < PPW; ++i_) { const int pc_ = w * PPW + i_, mat_ = pc_ / (PIECES / 2), pim_ = pc_ % (PIECES / 2), row_ = pim_ * RPP + rip; \
        const int c_ = mat_ ? ((((pos >> 2) ^ (row_ & (NC64 - 1))) << 2) | (pos & 3)) : (pos ^ (row_ & (NC - 1))); \
        glds16(P + (rowbase + 64 * (kt) + row_) * PITCH + (mat_ ? vcol : kcol) + 8 * c_, (unsigned)__builtin_amdgcn_readfirstlane((int)(lds0 + (slot) * TILEB + mat_ * KBYTES + pim_ * 1024))); } } while (0)
    __syncthreads();
#define AT_TILE(j) (SB ? NT - 1 - (j) : (j))
    AT_DMA(AT_TILE(0), 0); AT_DMA(AT_TILE(1), 1); AT_DMA(AT_TILE(2), 2);
    int cur = 0;
    const int blk = (lane >> 4) & 1, p4 = lane & 3, q4 = (lane & 15) >> 2;
    volatile LAS int* flg = (volatile LAS int*)(lds + MISC_OFF + 64);
    bool wdone = false;
    for (int j = 0; j < NT; ++j, cur = (cur + 1) & 3) {
        const int kt = AT_TILE(j);
        if (j + 2 < NT) { if (PPW == 2) asm volatile("s_waitcnt vmcnt(4)" ::: "memory"); else asm volatile("s_waitcnt vmcnt(8)" ::: "memory"); }
        else if (j + 1 < NT) { if (PPW == 2) asm volatile("s_waitcnt vmcnt(2)" ::: "memory"); else asm volatile("s_waitcnt vmcnt(4)" ::: "memory"); }
        else asm volatile("s_waitcnt vmcnt(0)" ::: "memory");
        if (SB && lane == 0) flg[(kt & 1) * 8 + w] = wdone ? 1 : 0;
        __syncthreads();
        if (SB) { const LAS int* f4 = (const LAS int*)(lds + MISC_OFF + 64 + (kt & 1) * 32); const int a0 = f4[0] & f4[1] & f4[2] & f4[3] & f4[4] & f4[5] & f4[6] & f4[7]; if (a0) break; }
        if (j + 3 < NT) AT_DMA(AT_TILE(j + 3), (cur + 3) & 3);
        const bool part = SB ? (64 * kt < wlo + 31 && !wdone) : (kt <= (wlo >> 6));
        if (part) {
            const LAS unsigned char* Kb = lds + cur * TILEB; const LAS unsigned char* Vb = Kb + KBYTES;
            f32x16 p0, p1;
#pragma unroll
            for (int r = 0; r < 16; ++r) { p0[r] = 0.f; p1[r] = 0.f; }
#pragma unroll
            for (int sb = 0; sb < NS / 4; ++sb) {
                bf16x8 kf0[4], kf1[4];
#pragma unroll
                for (int i = 0; i < 4; ++i) { const int c = 2 * (4 * sb + i) + hi;
                    kf0[i] = *(const LAS bf16x8*)(Kb + r32 * RB + ((c ^ (r32 & (NC - 1))) << 4));
                    kf1[i] = *(const LAS bf16x8*)(Kb + (32 + r32) * RB + ((c ^ (r32 & (NC - 1))) << 4)); }
                __builtin_amdgcn_sched_barrier(0);
#pragma unroll
                for (int i = 0; i < 4; ++i) { p0 = MFMA32(kf0[i], qf[4 * sb + i], p0); p1 = MFMA32(kf1[i], qf[4 * sb + i], p1); }
                __builtin_amdgcn_sched_barrier(0);
            }
            s16x4 vl[ND][4], vh[ND][4];
            if (SB) {
#pragma unroll
                for (int d0 = 0; d0 < ND; ++d0)
#pragma unroll
                    for (int ks = 0; ks < 4; ++ks) { const int rowA = 16 * ks + 4 * hi + q4, rowB = rowA + 8;
                        vl[d0][ks] = vtr(Vb + rowA * RB + ((d0 ^ (rowA & (NC64 - 1))) << 6) + 32 * blk + 8 * p4);
                        vh[d0][ks] = vtr(Vb + rowB * RB + ((d0 ^ (rowB & (NC64 - 1))) << 6) + 32 * blk + 8 * p4); }
                __builtin_amdgcn_sched_barrier(0);
            }
            if (SB) {
                if (64 * kt + 63 < wlo) { sb_block<false>(p1, 64 * kt + 32, tq, hi, carry); sb_block<false>(p0, 64 * kt, tq, hi, carry); }
                else { sb_block<true>(p1, 64 * kt + 32, tq, hi, carry); sb_block<true>(p0, 64 * kt, tq, hi, carry); }
                wdone = __all(carry < 1e-37f) != 0;
            } else if (kt == (wlo >> 6)) { ret_block(p1, 64 * kt + 32, tq, hi, lg2); ret_block(p0, 64 * kt, tq, hi, lg2); }
            else { const float f0 = __builtin_amdgcn_exp2f(lg2 * (float)(tq - 64 * kt - 4 * hi)); ret_block_f(p0, f0, g1, g8); ret_block_f(p1, f0 * c32, g1, g8); }
            bf16x8 pa[4];
            pa[0] = __builtin_bit_cast(bf16x8, PACK8(p0, 0)); pa[1] = __builtin_bit_cast(bf16x8, PACK8(p0, 1));
            pa[2] = __builtin_bit_cast(bf16x8, PACK8(p1, 0)); pa[3] = __builtin_bit_cast(bf16x8, PACK8(p1, 1));
#pragma unroll
            for (int ks = 0; ks < 4; ++ks) {
                if (!SB) {
                    const int rowA = 16 * ks + 4 * hi + q4, rowB = rowA + 8;
#pragma unroll
                    for (int d0 = 0; d0 < ND; ++d0) {
                        vl[d0][ks] = vtr(Vb + rowA * RB + ((d0 ^ (rowA & (NC64 - 1))) << 6) + 32 * blk + 8 * p4);
                        vh[d0][ks] = vtr(Vb + rowB * RB + ((d0 ^ (rowB & (NC64 - 1))) << 6) + 32 * blk + 8 * p4); }
                    __builtin_amdgcn_sched_barrier(0);
                }
#pragma unroll
                for (int d0 = 0; d0 < ND; ++d0) {
                    const bf16x8 vf = __builtin_shufflevector(vl[d0][ks], vh[d0][ks], 0, 1, 2, 3, 4, 5, 6, 7);
                    o[d0] = MFMA32(vf, pa[ks], o[d0]);
                }
                if (!SB) __builtin_amdgcn_sched_barrier(0);
            }
        }
    }
#undef AT_DMA
#undef AT_TILE
    asm volatile("s_waitcnt vmcnt(0)" ::: "memory");
    bf16* orow = P + (rowbase + wlo + r32) * PITCH + qcol + 4 * hi;
    float ss = 0.f;
#pragma unroll
    for (int d0 = 0; d0 < ND; ++d0)
#pragma unroll
        for (int r = 0; r < 16; ++r) ss += o[d0][r] * o[d0][r];
    ss += __shfl_xor(ss, 32);
    if (SB) {
        if (hi == 0) sbpart[(rowbase + wlo + r32) * 8 + h] = ss;
#pragma unroll
        for (int d0 = 0; d0 < ND; ++d0)
#pragma unroll
            for (int k = 0; k < 2; ++k) { u32x2 wa, wb; wa.x = cvtpk(o[d0][8 * k], o[d0][8 * k + 1]); wa.y = cvtpk(o[d0][8 * k + 2], o[d0][8 * k + 3]); wb.x = cvtpk(o[d0][8 * k + 4], o[d0][8 * k + 5]); wb.y = cvtpk(o[d0][8 * k + 6], o[d0][8 * k + 7]);
                *(u32x4*)(orow + 32 * d0 + 16 * k + 4 * hi) = widen_pair(wa, wb); }
    } else {
        const float rs = rsqrtf(ss * (1.0f / 128.0f) + EPS);
        u32x2 gt[ND][4]; f32x4 gr[ND][4];
#pragma unroll
        for (int d0 = 0; d0 < ND; ++d0)
#pragma unroll
            for (int g = 0; g < 4; ++g) { gt[d0][g] = *(const u32x2*)(orow + 1536 + 32 * d0 + 8 * g); gr[d0][g] = *(const f32x4*)(gret + h * 128 + 32 * d0 + 8 * g + 4 * hi); }
#pragma unroll
        for (int d0 = 0; d0 < ND; ++d0)
#pragma unroll
            for (int k = 0; k < 2; ++k) {
                u32x2 wv[2];
#pragma unroll
                for (int gi = 0; gi < 2; ++gi) { const int g = 2 * k + gi; const f32x4 gg = gr[d0][g] * rs;
                    wv[gi].x = cvtpk(o[d0][4 * g] * gg[0] * bflo(gt[d0][g].x), o[d0][4 * g + 1] * gg[1] * bfhi(gt[d0][g].x));
                    wv[gi].y = cvtpk(o[d0][4 * g + 2] * gg[2] * bflo(gt[d0][g].y), o[d0][4 * g + 3] * gg[3] * bfhi(gt[d0][g].y)); }
                *(u32x4*)(orow + 32 * d0 + 16 * k + 4 * hi) = widen_pair(wv[0], wv[1]);
            }
    }
}

__device__ __forceinline__ void sb_unit(LAS unsigned char* lds, bf16* P, int b, int h, int qb, float* sbpart) {
    constexpr int PITCH = INC, NS = 4, ND = 2, RB = 128;
    const int tid = tid_opaque(), lane = tid & 63, w = __builtin_amdgcn_readfirstlane(tid >> 6), r32 = lane & 31, hi = lane >> 5;
    const int qcol = 2048 + h * 64, kcol = 2560 + h * 64, vcol = 3072 + h * 64;
    const size_t rowbase = (size_t)b * SEQ;
    const int q0 = qb * 256, wlo = q0 + 32 * w, tq = wlo + r32;
    bf16x8 qf[NS];
    { const bf16* qp = P + (rowbase + tq) * PITCH + qcol + hi * 8;
#pragma unroll
      for (int s = 0; s < NS; ++s) qf[s] = *(const bf16x8*)(qp + 16 * s); }
#pragma unroll
    for (int s = 0; s < NS; ++s) asm volatile("" : "+v"(qf[s]));
    f32x16 o[ND];
#pragma unroll
    for (int d = 0; d < ND; ++d)
#pragma unroll
        for (int r = 0; r < 16; ++r) o[d][r] = 0.f;
    float carry = 1.0f;
    const unsigned wbase = (unsigned)(uintptr_t)lds + (unsigned)w * 16384u;
    const LAS unsigned char* wl = lds + w * 16384;
    const int rip = lane >> 3, pos = lane & 7;
#define SB_DMA(hb, slot) do { _Pragma("unroll") for (int pc_ = 0; pc_ < 8; ++pc_) { const int mat_ = pc_ >> 2, row_ = 8 * (pc_ & 3) + rip; \
        const int c_ = mat_ ? ((((pos >> 2) ^ (row_ & 1)) << 2) | (pos & 3)) : (pos ^ (row_ & 7)); \
        glds16(P + (rowbase + 32 * (hb) + row_) * PITCH + (mat_ ? vcol : kcol) + 8 * c_, (unsigned)__builtin_amdgcn_readfirstlane((int)(wbase + (slot) * 8192 + mat_ * 4096 + (pc_ & 3) * 1024))); } } while (0)
    const int hb0 = wlo >> 5;
    __syncthreads();
    SB_DMA(hb0, 0);
    const int blk = (lane >> 4) & 1, p4 = lane & 3, q4 = (lane & 15) >> 2;
    int sl = 0;
    for (int hb = hb0; hb >= 0; --hb, sl ^= 1) {
        if (hb > 0) { SB_DMA(hb - 1, sl ^ 1); asm volatile("s_waitcnt vmcnt(8)" ::: "memory"); }
        else asm volatile("s_waitcnt vmcnt(0)" ::: "memory");
        const LAS unsigned char* Kb = wl + sl * 8192; const LAS unsigned char* Vb = Kb + 4096;
        f32x16 p;
#pragma unroll
        for (int r = 0; r < 16; ++r) p[r] = 0.f;
        bf16x8 kf[NS];
#pragma unroll
        for (int s = 0; s < NS; ++s) kf[s] = *(const LAS bf16x8*)(Kb + r32 * RB + (((2 * s + hi) ^ (r32 & 7)) << 4));
        s16x4 vl[ND][2], vh[ND][2];
#pragma unroll
        for (int d0 = 0; d0 < ND; ++d0)
#pragma unroll
            for (int ks = 0; ks < 2; ++ks) { const int rowA = 16 * ks + 4 * hi + q4, rowB = rowA + 8;
                vl[d0][ks] = vtr(Vb + rowA * RB + ((d0 ^ (rowA & 1)) << 6) + 32 * blk + 8 * p4);
                vh[d0][ks] = vtr(Vb + rowB * RB + ((d0 ^ (rowB & 1)) << 6) + 32 * blk + 8 * p4); }
#pragma unroll
        for (int s = 0; s < NS; ++s) p = MFMA32(kf[s], qf[s], p);
        if (32 * hb + 31 < wlo) sb_block<false>(p, 32 * hb, tq, hi, carry); else sb_block<true>(p, 32 * hb, tq, hi, carry);
        bf16x8 pa[2];
        pa[0] = __builtin_bit_cast(bf16x8, PACK8(p, 0)); pa[1] = __builtin_bit_cast(bf16x8, PACK8(p, 1));
#pragma unroll
        for (int ks = 0; ks < 2; ++ks)
#pragma unroll
            for (int d0 = 0; d0 < ND; ++d0) {
                const bf16x8 vf = __builtin_shufflevector(vl[d0][ks], vh[d0][ks], 0, 1, 2, 3, 4, 5, 6, 7);
                o[d0] = MFMA32(vf, pa[ks], o[d0]);
            }
        if (__all(carry < 1e-37f)) break;
    }
#undef SB_DMA
    asm volatile("s_waitcnt vmcnt(0)" ::: "memory");
    bf16* orow = P + (rowbase + wlo + r32) * PITCH + qcol + 4 * hi;
    float ss = 0.f;
#pragma unroll
    for (int d0 = 0; d0 < ND; ++d0)
#pragma unroll
        for (int r = 0; r < 16; ++r) ss += o[d0][r] * o[d0][r];
    ss += __shfl_xor(ss, 32);
    if (hi == 0) sbpart[(rowbase + wlo + r32) * 8 + h] = ss;
#pragma unroll
    for (int d0 = 0; d0 < ND; ++d0)
#pragma unroll
        for (int k = 0; k < 2; ++k) { u32x2 wa, wb; wa.x = cvtpk(o[d0][8 * k], o[d0][8 * k + 1]); wa.y = cvtpk(o[d0][8 * k + 2], o[d0][8 * k + 3]); wb.x = cvtpk(o[d0][8 * k + 4], o[d0][8 * k + 5]); wb.y = cvtpk(o[d0][8 * k + 6], o[d0][8 * k + 7]);
            *(u32x4*)(orow + 32 * d0 + 16 * k + 4 * hi) = widen_pair(wa, wb); }
}

__device__ __forceinline__ void xattn_unit(LAS unsigned char* lds, const bf16* Q, const bf16* KV, const float* qpart, bf16* O, int b, int h, int tb) {
    const int tid = tid_opaque(), lane = tid & 63, w = __builtin_amdgcn_readfirstlane(tid >> 6), r32 = lane & 31, hi = lane >> 5;
    const size_t Rw = (size_t)b * SEQ + tb * 256 + 32 * w, R = Rw + r32;
    const bf16* kvb = KV + (size_t)b * NMEM * 2048 + h * 256;
    const unsigned ldsb = (unsigned)(uintptr_t)lds; const int rip = lane >> 5, pos = lane & 31;
    __syncthreads();
#pragma unroll
    for (int i = 0; i < 16; ++i) { const int pim = w * 16 + i, row = 2 * pim + rip, c = pos ^ (row & 31);
        glds16(kvb + (size_t)row * 2048 + c * 8, (unsigned)__builtin_amdgcn_readfirstlane((int)(ldsb + pim * 1024))); }
    asm volatile("s_waitcnt vmcnt(0)" ::: "memory");
    __syncthreads();
    const bf16* qp = Q + R * DM + h * 256 + hi * 8;
    const f32x4 qq = *(const f32x4*)(qpart + R * 16 + h * 4);
    const float rq = rsqrtf(((qq[0] + qq[1]) + (qq[2] + qq[3])) * (1.0f / 256.0f) + EPS);
    float l = 0.f; bf16x8 pa[8][2];
#pragma unroll
    for (int half = 0; half < 2; ++half) {
        f32x16 p[4];
#pragma unroll
        for (int kb = 0; kb < 4; ++kb)
#pragma unroll
            for (int r = 0; r < 16; ++r) p[kb][r] = 0.f;
#pragma unroll
        for (int s = 0; s < 16; ++s) {
            const bf16x8 qf = *(const bf16x8*)(qp + 16 * s); const int c = 2 * s + hi;
#pragma unroll
            for (int kb = 0; kb < 4; ++kb) { const bf16x8 kf = *(const LAS bf16x8*)(lds + (128 * half + 32 * kb + r32) * 512 + ((c ^ r32) << 4)); p[kb] = MFMA32(kf, qf, p[kb]); }
        }
        if (half == 1) {
            asm volatile("s_waitcnt lgkmcnt(0)" ::: "memory");
            __syncthreads();
#pragma unroll
            for (int i = 0; i < 16; ++i) { const int pim = w * 16 + i, row = 2 * pim + rip, c = (((pos >> 2) ^ (row & 7)) << 2) | (pos & 3);
                glds16(kvb + 1024 + (size_t)row * 2048 + c * 8, (unsigned)__builtin_amdgcn_readfirstlane((int)(ldsb + pim * 1024))); __builtin_amdgcn_sched_barrier(0); }
        }
#pragma unroll
        for (int kb = 0; kb < 4; ++kb) {
#pragma unroll
            for (int r = 0; r < 16; ++r) { const float e = __builtin_amdgcn_exp2f(p[kb][r] * rq); l += e; p[kb][r] = e; }
            pa[4 * half + kb][0] = __builtin_bit_cast(bf16x8, PACK8(p[kb], 0)); pa[4 * half + kb][1] = __builtin_bit_cast(bf16x8, PACK8(p[kb], 1));
        }
    }
    l += __shfl_xor(l, 32);
    const float rl = 1.0f / l;
    asm volatile("s_waitcnt vmcnt(0)" ::: "memory");
    __syncthreads();
    const int blk = (lane >> 4) & 1, p4 = lane & 3, q4 = (lane & 15) >> 2;
    bf16* op = O + R * DM + h * 256 + 4 * hi;
#pragma unroll
    for (int dp = 0; dp < 4; ++dp) {
        f32x16 oa[2], ob[2];
#pragma unroll
        for (int e = 0; e < 2; ++e)
#pragma unroll
            for (int r = 0; r < 16; ++r) { oa[e][r] = 0.f; ob[e][r] = 0.f; }
#pragma unroll
        for (int ks = 0; ks < 16; ks += 2) {
            s16x4 lo[2][2], hh[2][2];
#pragma unroll
            for (int kk = 0; kk < 2; ++kk) { const int rowA = 16 * (ks + kk) + 4 * hi + q4, rowB = rowA + 8;
#pragma unroll
                for (int e = 0; e < 2; ++e) { const int d0 = 2 * dp + e;
                    lo[kk][e] = vtr(lds + rowA * 512 + ((d0 ^ (rowA & 7)) << 6) + 32 * blk + 8 * p4);
                    hh[kk][e] = vtr(lds + rowB * 512 + ((d0 ^ (rowB & 7)) << 6) + 32 * blk + 8 * p4); } }
#pragma unroll
            for (int e = 0; e < 2; ++e) {
                oa[e] = MFMA32(__builtin_shufflevector(lo[0][e], hh[0][e], 0, 1, 2, 3, 4, 5, 6, 7), pa[ks >> 1][0], oa[e]);
                ob[e] = MFMA32(__builtin_shufflevector(lo[1][e], hh[1][e], 0, 1, 2, 3, 4, 5, 6, 7), pa[ks >> 1][1], ob[e]);
            }
        }
#pragma unroll
        for (int e = 0; e < 2; ++e)
#pragma unroll
            for (int k = 0; k < 2; ++k) {
                u32x2 wv[2];
#pragma unroll
                for (int gi = 0; gi < 2; ++gi) { const int g = 2 * k + gi;
                    wv[gi].x = cvtpk((oa[e][4 * g] + ob[e][4 * g]) * rl, (oa[e][4 * g + 1] + ob[e][4 * g + 1]) * rl); wv[gi].y = cvtpk((oa[e][4 * g + 2] + ob[e][4 * g + 2]) * rl, (oa[e][4 * g + 3] + ob[e][4 * g + 3]) * rl); }
                *(u32x4*)(op + 32 * (2 * dp + e) + 16 * k + 4 * hi) = widen_pair(wv[0], wv[1]); }
    }
}

#define XB_TMO      128
#define XB_XCNT(j)  (256  + 64 * (j))
#define XB_XSUB(j)  (1280 + 64 * (j))
#define XB_XGEN(j)  (2304 + 64 * (j))
#define XB_TOP      3328
#define XB_TOPGEN   3392
#define XCD_BAR_WORDS 3456
#define XB_SPIN_CAP (1u << 18)

__device__ __forceinline__ unsigned xb_ld(unsigned* p)              { return __hip_atomic_load(p, __ATOMIC_RELAXED, __HIP_MEMORY_SCOPE_AGENT); }
__device__ __forceinline__ unsigned xb_add(unsigned* p, unsigned v) { return __hip_atomic_fetch_add(p, v, __ATOMIC_RELAXED, __HIP_MEMORY_SCOPE_AGENT); }
__device__ __forceinline__ unsigned xb_xcc_id() { return (unsigned)__builtin_amdgcn_s_getreg((3 << 11) | 20) & 0xFu; }
#define XB_SPIN(cond, bar) do { unsigned _sp = 0; while (cond) { __builtin_amdgcn_s_sleep(1); \
    if ((++_sp & 255u) == 0u) { if (xb_ld(&(bar)[XB_TMO])) break; if (_sp > XB_SPIN_CAP) { atomicAdd(&(bar)[XB_TMO], 1u); break; } } } } while (0)

struct XcdBarrier {
    unsigned* bar; unsigned x;
    volatile LAS unsigned* st;
};

__device__ __forceinline__ XcdBarrier xcd_barrier_post(unsigned* bar, volatile LAS unsigned* st) {
    XcdBarrier b; b.bar = bar; b.x = xb_xcc_id(); b.st = st;
    if (threadIdx.x == 0) (void)xb_add(&bar[XB_XCNT(b.x)], 1u);
    return b;
}
__device__ __forceinline__ void xcd_barrier_complete(unsigned* bar, unsigned x, unsigned& nloc, unsigned& nx) {
    const unsigned G = gridDim.x * gridDim.y * gridDim.z;
    unsigned sum, cnt, mine, sp = 0u;
    for (;;) {
        sum = 0u; cnt = 0u; mine = 0u;
#pragma unroll
        for (unsigned j = 0; j < 16; ++j) { const unsigned c = xb_ld(&bar[XB_XCNT(j)]); sum += c; cnt += (c > 0u) ? 1u : 0u; mine = (j == x) ? c : mine; }
        if (sum == G) break;
        __builtin_amdgcn_s_sleep(1);
        if ((++sp & 255u) == 0u) { if (xb_ld(&bar[XB_TMO])) break; if (sp > XB_SPIN_CAP) { atomicAdd(&bar[XB_TMO], 1u); break; } }
    }
    nloc = mine > 0u ? mine : 1u; nx = cnt > 0u ? cnt : 1u;
}

__device__ __forceinline__ void xcd_barrier(const XcdBarrier& b) {
    asm volatile("s_waitcnt vmcnt(0)" ::: "memory");
    __syncthreads();
    if (threadIdx.x == 0) {
        unsigned* bar = b.bar;
        __builtin_amdgcn_s_waitcnt(0);
        unsigned nloc = b.st[0], nx = b.st[1];
        if (nloc == 0u) { xcd_barrier_complete(bar, b.x, nloc, nx); b.st[0] = nloc; b.st[1] = nx; }
        const unsigned old = xb_add(&bar[XB_XSUB(b.x)], 1u);
        const unsigned gen = old / nloc;
        if (old + 1u == (gen + 1u) * nloc) {
            __builtin_amdgcn_fence(__ATOMIC_RELEASE, "agent");
            asm volatile("s_waitcnt vmcnt(0)" ::: "memory");
            const unsigned og = xb_add(&bar[XB_TOP], 1u);
            const unsigned tg = og / nx;
            if (og + 1u == (tg + 1u) * nx) xb_add(&bar[XB_TOPGEN], 1u);
            else XB_SPIN(xb_ld(&bar[XB_TOPGEN]) == tg, bar);
            __builtin_amdgcn_fence(__ATOMIC_ACQUIRE, "agent");
            xb_add(&bar[XB_XGEN(b.x)], 1u);
            asm volatile("s_waitcnt vmcnt(0)" ::: "memory");
        } else {
            XB_SPIN(xb_ld(&bar[XB_XGEN(b.x)]) == gen, bar);
            __builtin_amdgcn_fence(__ATOMIC_ACQUIRE, "agent");
            asm volatile("s_waitcnt vmcnt(0)" ::: "memory");
        }
    }
    __syncthreads();
}

struct Args { const float* in[17]; float* out; unsigned char* ws; };
typedef const __attribute__((address_space(4))) Args* cargs_t;
__device__ __forceinline__ cargs_t get_args() { cargs_t p = (cargs_t)__builtin_amdgcn_kernarg_segment_ptr(); asm volatile("" : "+s"(p)); return p; }
#define PHASE_VARS cargs_t A = get_args(); unsigned char* ws = A->ws; const int tid = tid_opaque(), lane = tid & 63, wave = __builtin_amdgcn_readfirstlane(tid >> 6), G = gridDim.x, bx = blockIdx.x, gw = bx * 8 + wave, NGW = G * 8; (void)lane; (void)gw; (void)NGW; (void)ws
#define P_XB ((bf16*)(ws + WS_XB))
#define P_R1 ((bf16*)(ws + WS_R1))
#define P_O ((bf16*)(ws + WS_O))
#define P_KV ((bf16*)(ws + WS_KV))
#define P_MEMB ((bf16*)(ws + WS_MEMB))
#define P_XSS(slot) ((float*)(ws + WS_XSS) + (size_t)(slot) * T_TOK)
#define P_QPART ((float*)(ws + WS_QPART))
#define P_KPART ((float*)(ws + WS_KPART))
#define P_MSS ((float*)(ws + WS_MSS))
#define P_CTR ((int*)(ws + WS_CTR))
#define P_WL(l) ((const bf16*)(ws + WS_W + (size_t)(l) * W_LAYER))

__global__ void __launch_bounds__(512, 2) hymba_fwd(Args a_unused) {
    extern __shared__ __attribute__((aligned(16))) unsigned char lds_raw[];
    LAS unsigned char* lds = (LAS unsigned char*)lds_raw;
    cg::grid_group grid = cg::this_grid();
    if (threadIdx.x < 8) ((volatile LAS unsigned*)(lds + MISC_OFF + 128))[threadIdx.x] = 0u;
    __syncthreads();
    { cargs_t A0 = get_args(); (void)xcd_barrier_post((unsigned*)(A0->ws + WS_BAR), (volatile LAS unsigned*)(lds + MISC_OFF + 128)); }
    if (gridDim.x == 0x7fffffffu) grid.sync();
#define GRID_SYNC() do { XcdBarrier b_; b_.bar = (unsigned*)(get_args()->ws + WS_BAR); b_.x = xb_xcc_id(); b_.st = (volatile LAS unsigned*)(lds + MISC_OFF + 128); xcd_barrier(b_); } while (0)

    {
        PHASE_VARS;
        LAS float* scr = (LAS float*)(lds + wave * 16384);
        constexpr int I_IN = 32 * (INC / 64), I_SQ = 32 * 16, I_KV = 32 * 32, I_UP = 32 * 64, I_DN = 128 * 16;
        constexpr int PER_LAYER = I_IN + 3 * I_SQ + I_KV + I_UP + I_DN;
        for (int it = gw; it < 2 * PER_LAYER; it += NGW) {
            const int itr = 2 * PER_LAYER - 1 - it;
            const int l = itr / PER_LAYER; int r = itr % PER_LAYER;
            bf16* wl = (bf16*)(ws + WS_W + (size_t)l * W_LAYER);
            if (r < I_IN) { transpose_item(A->in[3] + (size_t)l * DM * INC, DM, INC, wl + WO_IN / 2, A->in[2] + l * DM, true, scr, r, lane); continue; } r -= I_IN;
            if (r < I_SQ) { transpose_item(A->in[6] + (size_t)l * DM * DM, DM, DM, wl + WO_MIX / 2, A->in[5] + l * 512, false, scr, r, lane, 512, 512); continue; } r -= I_SQ;
            if (r < I_SQ) { transpose_item(A->in[9] + (size_t)l * DM * DM, DM, DM, wl + WO_XQ / 2, A->in[7] + l * DM, false, scr, r, lane); continue; } r -= I_SQ;
            if (r < I_KV) { transpose_item(A->in[10] + (size_t)l * DM * 2048, DM, 2048, wl + WO_XKV / 2, A->in[8] + l * DM, false, scr, r, lane); continue; } r -= I_KV;
            if (r < I_SQ) { transpose_item(A->in[13] + (size_t)l * DM * DM, DM, DM, wl + WO_XO / 2, nullptr, false, scr, r, lane); continue; } r -= I_SQ;
            if (r < I_UP) { transpose_item(A->in[15] + (size_t)l * DM * FF, DM, FF, wl + WO_UP / 2, A->in[14] + l * DM, false, scr, r, lane); continue; } r -= I_UP;
            transpose_item(A->in[16] + (size_t)l * FF * DM, FF, DM, wl + WO_DOWN / 2, nullptr, false, scr, r, lane);
        }
        const float* x_in = A->in[0]; const float* mem = A->in[1];
        for (int m = 2 * gw; m < T_TOK; m += 2 * NGW) rows2_to_bf16(x_in + (size_t)m * DM, P_XB + (size_t)m * DM, P_XSS(0) + m, lane);
        for (int m = 2 * gw; m < MROWS; m += 2 * NGW) rows2_to_bf16(mem + (size_t)m * DM, P_MEMB + (size_t)m * DM, P_MSS + m, lane);
        if (bx == 0 && tid < 16) P_CTR[tid] = 0;
    }
    GRID_SYNC();

    for (int l = 0; l < 2; ++l) {
        asm volatile("" : "+s"(l));
        {
            PHASE_VARS;
            pg8::Gemm g{P_XB, P_WL(l) + WO_IN / 2, T_TOK, INC, DM, DM, 1 << 30, 0l, nullptr}; pg8::StaticOrder S; S.init(T_TOK, INC, G, bx);
            pg8::EpiB<pg8::EM_PROJ> E{P_R1, INC, P_XSS(3 * l), nullptr};
            pg8::gemm_phase(lds, g, S, E);
        }
        {
            PHASE_VARS;
            pg8::Gemm g2{P_MEMB, P_WL(l) + WO_XKV / 2, MROWS, 2048, DM, DM, 1 << 30, 0l, nullptr}; pg8::StaticOrder S2; S2.init(MROWS, 2048, G, G - 1 - bx);
            pg8::EpiB<pg8::EM_KV> E2{P_KV, 2048, P_MSS, P_KPART};
            pg8::gemm_phase(lds, g2, S2, E2);
        }
        GRID_SYNC();
        {
            PHASE_VARS;
            const float* gqn = A->in[11] + l * 256; const float* gkn = A->in[12] + l * 256;
            bf16* kv = P_KV; const float* kpart = P_KPART;
            for (int it = gw; it < MROWS * 4; it += NGW) {
                const int row = it >> 2, hh = it & 3;
                const f32x4 kp = *(const f32x4*)(kpart + (size_t)row * 16 + hh * 4);
                const float rk = rsqrtf(((kp[0] + kp[1]) + (kp[2] + kp[3])) * (1.0f / 256.0f) + EPS) * (0.0625f * 1.4426950408889634f);
                u32x2* p = (u32x2*)(kv + (size_t)row * 2048 + hh * 256) + lane;
                const u32x2 v = *p; const f32x4 g1 = *((const f32x4*)gqn + lane), g2 = *((const f32x4*)gkn + lane);
                u32x2 o; o.x = cvtpk(bflo(v.x) * rk * g1[0] * g2[0], bfhi(v.x) * rk * g1[1] * g2[1]); o.y = cvtpk(bflo(v.y) * rk * g1[2] * g2[2], bfhi(v.y) * rk * g1[3] * g2[3]);
                *p = o;
            }
        }
        {
            PHASE_VARS;
            volatile LAS int* misc = (volatile LAS int*)(lds + MISC_OFF);
            const float* gret = A->in[4] + l * 512;
            for (int u = bx; u < 256; u += G) { const int bb = u & 7, idx = u >> 3, hh = idx >> 3, qb = idx & 7; attn_unit<128, false>(lds, P_R1, bb, hh, qb, log2f(1.0f - exp2f(-5.0f - (float)hh)), gret, nullptr); }
            for (;;) {
                if (tid == 0) misc[0] = atomicAdd(P_CTR + l, 1);
                __syncthreads();
                const int u = misc[0];
                __syncthreads();
                if (u >= 512) break;
                const int qb = 7 - (u >> 6), j = u & 63; sb_unit(lds, P_R1, j >> 3, j & 7, qb, P_QPART);
            }
        }
        GRID_SYNC();
        {
            PHASE_VARS;
            pg8::Gemm g{P_R1 + 2048, P_WL(l) + WO_MIX / 2, T_TOK, DM, DM, INC, 8, -5120l, P_QPART}; pg8::StaticOrder S; S.init(T_TOK, DM, G, bx);
            pg8::EpiRes<false> E{nullptr, P_XB, P_XSS(3 * l + 1)};
            if (G >= 256) {
                pg8::Unit u0;
                if (S.next(0, u0) && tid < 256) { const float* hp = P_QPART + (size_t)(u0.pm * 256 + tid) * 8; const f32x4 s0 = *(const f32x4*)hp, s1 = *(const f32x4*)(hp + 4);
                    ((LAS float*)(lds + MISC_OFF + 1024))[tid] = rsqrtf((((s0[0] + s0[1]) + (s0[2] + s0[3])) + ((s1[0] + s1[1]) + (s1[2] + s1[3]))) * (1.0f / 512.0f) + EPS); }
                __syncthreads();
                pg8::gemm_phase<2>(lds, g, S, E);
            } else pg8::gemm_phase<1>(lds, g, S, E);
        }
        GRID_SYNC();
        {
            PHASE_VARS;
            pg8::Gemm g{P_XB, P_WL(l) + WO_XQ / 2, T_TOK, DM, DM, DM, 1 << 30, 0l, nullptr}; pg8::StaticOrder S; S.init(T_TOK, DM, G, bx);
            pg8::EpiB<pg8::EM_Q> E{P_R1, DM, P_XSS(3 * l + 1), P_QPART};
            pg8::gemm_phase(lds, g, S, E);
        }
        {
            PHASE_VARS;
            __syncthreads();
            pg8::StaticOrder S; S.init(T_TOK, DM, G, bx); pg8::Unit u;
            for (int i = 0; S.next(i, u); ++i) xattn_unit(lds, P_R1, P_KV, P_QPART, P_O, u.pm >> 3, u.pn, u.pm & 7);
        }
        GRID_SYNC();
        {
            PHASE_VARS;
            pg8::Gemm g{P_O, P_WL(l) + WO_XO / 2, T_TOK, DM, DM, DM, 1 << 30, 0l, nullptr}; pg8::StaticOrder S; S.init(T_TOK, DM, G, bx);
            pg8::EpiRes<false> E{nullptr, P_XB, P_XSS(3 * l + 2)};
            pg8::gemm_phase(lds, g, S, E);
        }
        GRID_SYNC();
        {
            PHASE_VARS;
            pg8::Gemm g{P_XB, P_WL(l) + WO_UP / 2, T_TOK, FF, DM, DM, 1 << 30, 0l, nullptr}; pg8::StaticOrder S; S.init(T_TOK, FF, G, bx);
            g.pub = (int*)(ws + WS_PUB) + l * 4096;
            pg8::EpiB<pg8::EM_UP> E{P_R1, FF, P_XSS(3 * l + 2), nullptr};
            pg8::gemm_phase<false, true>(lds, g, S, E);
        }
        {
            PHASE_VARS;
            {
                pg8::StaticOrder Sw; Sw.init(T_TOK, DM, G, bx); pg8::Unit uw;
                if (wave == 0) {
                    int* pub = (int*)(ws + WS_PUB) + l * 4096;
                    for (int i = 0; Sw.next(i, uw); ++i) {
                        unsigned spins = 0;
                        while (__builtin_amdgcn_readfirstlane(__hip_atomic_load(pub + 64 * uw.pm, __ATOMIC_RELAXED, __HIP_MEMORY_SCOPE_AGENT)) < 128) { __builtin_amdgcn_s_sleep(2); if (++spins > (1u << 22)) break; }
                    }
                    __builtin_amdgcn_fence(__ATOMIC_ACQUIRE, "agent");
                    asm volatile("s_waitcnt vmcnt(0)" ::: "memory");
                }
                __syncthreads();
            }
            pg8::Gemm g{P_R1, P_WL(l) + WO_DOWN / 2, T_TOK, DM, FF, FF, 1 << 30, 0l, nullptr}; pg8::StaticOrder S; S.init(T_TOK, DM, G, bx);
            if (l == 1) { pg8::EpiRes<true> E{A->out, P_XB, nullptr}; pg8::gemm_phase(lds, g, S, E); }
            else { pg8::EpiRes<false> E{nullptr, P_XB, P_XSS(3 * l + 3)}; pg8::gemm_phase(lds, g, S, E); }
        }
        if (l == 0) GRID_SYNC();
    }
}

extern "C" void kernel_launch(void* const* d_in, const int* in_sizes, int n_in, void* d_out, int out_size, void* d_ws, size_t ws_size, hipStream_t stream) {
    static int grid = 0;
    if (grid == 0) {
        if (n_in != 17 || ws_size < WS_END) { fprintf(stderr, "kernel_launch: unexpected n_in %d / ws_size %zu\n", n_in, ws_size); grid = -1; return; }
        int dev = 0, cus = 0, per_cu = 0;
        hipGetDevice(&dev);
        hipDeviceGetAttribute(&cus, hipDeviceAttributeMultiprocessorCount, dev);
        hipFuncSetAttribute((const void*)hymba_fwd, hipFuncAttributeMaxDynamicSharedMemorySize, LDS_BYTES);
        hipOccupancyMaxActiveBlocksPerMultiprocessor(&per_cu, (const void*)hymba_fwd, 512, LDS_BYTES);
        if (per_cu < 1) { fprintf(stderr, "kernel_launch: occupancy query reports %d blocks per CU\n", per_cu); per_cu = 1; }
        grid = cus;
    }
    if (grid < 0) return;
    if (hipMemsetAsync((char*)d_ws + WS_CTR, 0, WS_CTL_BYTES, stream) != hipSuccess) { fprintf(stderr, "kernel_launch: memset of control words failed\n"); return; }
    Args a{};
    for (int i = 0; i < 17; ++i) a.in[i] = (const float*)d_in[i];
    a.out = (float*)d_out; a.ws = (unsigned char*)d_ws;
    void* args[] = {&a};
    hipError_t e = hipLaunchCooperativeKernel((const void*)hymba_fwd, dim3(grid), dim3(512), args, LDS_BYTES, stream);
    if (e != hipSuccess) fprintf(stderr, "cooperative launch failed: %s (grid %d)\n", hipGetErrorString(e), grid);
}
```

```cpp
#include <hip/hip_runtime.h>
#include <hip/hip_cooperative_groups.h>
#include <cstdio>
#include <cstdint>
namespace cg = cooperative_groups;

#define LAS __attribute__((address_space(3)))
typedef unsigned short bf16;
typedef short bf16x8 __attribute__((ext_vector_type(8)));
typedef short s16x4 __attribute__((ext_vector_type(4)));
typedef float f32x2 __attribute__((ext_vector_type(2)));
typedef float f32x4 __attribute__((ext_vector_type(4)));
typedef float f32x16 __attribute__((ext_vector_type(16)));
typedef unsigned u32x2 __attribute__((ext_vector_type(2)));
typedef unsigned u32x4 __attribute__((ext_vector_type(4)));
typedef __bf16 bf16x2_t __attribute__((ext_vector_type(2)));

constexpr int T_TOK = 16384, DM = 1024, SEQ = 2048, NB = 8, NMEM = 256, MROWS = NB * NMEM, INC = 3584, FF = 4096;
constexpr float EPS = 1e-6f;
constexpr size_t MiB = 1u << 20;
constexpr size_t WS_W = 0, W_LAYER = 33 * MiB;
constexpr size_t WO_IN = 0, WO_MIX = 3584ull * 2048, WO_XQ = 4608ull * 2048, WO_XKV = 5632ull * 2048, WO_XO = 7680ull * 2048, WO_UP = 8704ull * 2048, WO_DOWN = 12800ull * 2048;
constexpr size_t WS_XB = 66 * MiB;
constexpr size_t WS_R1 = 98 * MiB;
constexpr size_t WS_O = WS_R1 + 32 * MiB;
constexpr size_t WS_KV = 226 * MiB;
constexpr size_t WS_MEMB = 234 * MiB;
constexpr size_t WS_XPART = 238 * MiB;
constexpr size_t WS_QPART = 239 * MiB;
constexpr size_t WS_KPART = 240 * MiB;
constexpr size_t WS_MPART = WS_KPART + 256 * 1024;
constexpr size_t WS_CTR = 241 * MiB;
constexpr size_t WS_PUB = WS_CTR + 32768;
constexpr size_t WS_BAR = WS_CTR + 4096;
constexpr size_t WS_XSS = WS_CTR + 65536;
constexpr size_t WS_MSS = WS_XSS + 7 * 65536;
constexpr size_t WS_CTL_BYTES = 65536 + 7 * 65536 + 8192;
constexpr size_t WS_END = 242 * MiB;
constexpr int LDS_BYTES = 147456, MISC_OFF = 131072;

__device__ __forceinline__ unsigned cvtpk(float lo, float hi) { f32x2 v = {lo, hi}; bf16x2_t b = __builtin_convertvector(v, bf16x2_t); return __builtin_bit_cast(unsigned, b); }
__device__ __forceinline__ float bf2f(unsigned short h) { return __uint_as_float(((unsigned)h) << 16); }
__device__ __forceinline__ float bflo(unsigned w) { return __uint_as_float(w << 16); }
__device__ __forceinline__ float bfhi(unsigned w) { return __uint_as_float(w & 0xffff0000u); }
__device__ __forceinline__ int tid_opaque() { int t = threadIdx.x; asm volatile("" : "+v"(t)); return t; }
__device__ __forceinline__ int crow(int r, int hi) { return (r & 3) + 8 * (r >> 2) + 4 * hi; }
__device__ __forceinline__ float wave_sum(float v) {
#pragma unroll
    for (int o = 1; o < 64; o <<= 1) v += __shfl_xor(v, o);
    return v;
}

template <int OFF> __device__ __forceinline__ void store16_wt(void* p, u32x4 v) { asm volatile("global_store_dwordx4 %0, %1, off offset:%2 sc1\n\ts_nop 1" :: "v"(p), "v"(v), "n"(OFF) : "memory"); }

namespace pg8 {
constexpr int BM = 256, BK = 64, HALF = 128, HTB = HALF * BK * 2, STAGE_BYTES = 8 * HTB, NXCD = 8, WGM = 8;
__host__ __device__ __forceinline__ int lds_byte(int r, int c) { const int st = (r >> 4) * 2 + (c >> 5), rr = r & 15, cc = c & 31, ob = rr * 64 + cc * 2; return st * 1024 + (ob ^ (((ob >> 9) & 1) << 5)); }
__host__ __device__ __forceinline__ void stage_rc(int b, int& R, int& C) { const int st = b / 1024, sb = b % 1024, swz = sb ^ (((sb >> 9) & 1) << 5); R = (st >> 1) * 16 + swz / 64; C = (st & 1) * 32 + (swz % 64) / 2; }
__host__ __device__ __forceinline__ int perm32(int rho) { const int n = rho >> 4, i = rho & 15; return 8 * (i >> 2) + 4 * n + (i & 3); }

struct Unit { int pm, pn; };
struct Gemm { const bf16* A; const bf16* Bt; int M, N, K, lda; int tj; long ajump; const float* hpart; int* pub = nullptr; };

struct StaticOrder {
    int nM, nN, nwg, G, c;
    __host__ __device__ void init(int M, int N, int G_, int c_) { nM = M / BM; nN = N / BM; nwg = nM * nN; G = G_; c = c_; }
    __host__ __device__ bool next(int i, Unit& u) const {
        const long L = (long)i * G + c; if (L >= nwg) return false;
        int wgid = (int)L; { const int q = nwg / NXCD, r = nwg % NXCD, xcd = wgid % NXCD, off = wgid / NXCD; wgid = (xcd < r ? xcd * (q + 1) : r * (q + 1) + (xcd - r) * q) + off; }
        const int nig = WGM * nN, gid = wgid / nig, fm = gid * WGM, gsz = (nM - fm) < WGM ? (nM - fm) : WGM;
        u.pm = fm + ((wgid % nig) % gsz); u.pn = (wgid % nig) / gsz; return true;
    }
};

enum { EM_PROJ = 0, EM_Q = 1, EM_UP = 2, EM_KV = 3 };
template <int MODE> struct EpiB {
    static constexpr bool PERM = true;
    bf16* O; int ldc; const float* part; float* opart;
    __device__ __forceinline__ void operator()(const f32x4 (&acc)[2][2][4][2], const Unit& u, int wr, int wc, int fr, int fq) const {
        const int row0 = u.pm * BM + wr * 64 + fr;
        const int colL = wc * 32 + 8 * fq;
        const int tt = u.pn >> 1;
        float inv[4];
        if (MODE == EM_PROJ) {
#pragma unroll
            for (int e = 0; e < 4; ++e) inv[e] = __builtin_amdgcn_exp2f(-(float)(16 * wc + 4 * fq + e) * (13.287712379549449f / 63.0f)) * 0.15915494309189535f;
        }
        float ssr[2][4];
#pragma unroll
        for (int ai = 0; ai < 2; ++ai)
#pragma unroll
            for (int m = 0; m < 4; ++m) ssr[ai][m] = part[row0 + ai * HALF + m * 16];
#pragma unroll
        for (int ai = 0; ai < 2; ++ai)
#pragma unroll
            for (int m = 0; m < 4; ++m) {
                const int row = row0 + ai * HALF + m * 16;
                const float rstd = rsqrtf(ssr[ai][m] * (1.0f / 1024.0f) + EPS);
                float sn[4], cs[4];
                if (MODE == EM_PROJ && tt <= 1) {
                    const float pos = (float)(row & (SEQ - 1));
#pragma unroll
                    for (int e = 0; e < 4; ++e) { const float rev = __builtin_amdgcn_fractf(pos * inv[e]); sn[e] = __builtin_amdgcn_sinf(rev); cs[e] = __builtin_amdgcn_cosf(rev); }
                }
                float sq = 0.f;
                bf16* rowp = O + (size_t)row * ldc + u.pn * BM + colL;
#pragma unroll
                for (int bj = 0; bj < 2; ++bj) {
                    f32x4 v0 = acc[ai][bj][m][0] * rstd, v1 = acc[ai][bj][m][1] * rstd;
                    if (MODE == EM_PROJ) {
                        if (tt <= 1) {
                            const float sc = (tt == 1) ? 0.08838834764831845f : 1.0f;
                            f32x4 a0, a1;
                            a0[0] = (v0[0] * cs[0] - v0[1] * sn[0]) * sc; a0[1] = (v0[0] * sn[0] + v0[1] * cs[0]) * sc;
                            a0[2] = (v0[2] * cs[1] - v0[3] * sn[1]) * sc; a0[3] = (v0[2] * sn[1] + v0[3] * cs[1]) * sc;
                            a1[0] = (v1[0] * cs[2] - v1[1] * sn[2]) * sc; a1[1] = (v1[0] * sn[2] + v1[1] * cs[2]) * sc;
                            a1[2] = (v1[2] * cs[3] - v1[3] * sn[3]) * sc; a1[3] = (v1[2] * sn[3] + v1[3] * cs[3]) * sc;
                            v0 = a0; v1 = a1;
                        } else if (tt == 3) {
#pragma unroll
                            for (int j = 0; j < 4; ++j) { v0[j] = v0[j] * __builtin_amdgcn_rcpf(1.0f + __builtin_amdgcn_exp2f(-1.4426950408889634f * v0[j])); v1[j] = v1[j] * __builtin_amdgcn_rcpf(1.0f + __builtin_amdgcn_exp2f(-1.4426950408889634f * v1[j])); }
                        } else if (tt == 4) { v0 = v0 * 0.18033688011112042f; v1 = v1 * 0.18033688011112042f; }
                    } else if (MODE == EM_UP) {
#pragma unroll
                        for (int j = 0; j < 4; ++j) { const float a = fmaxf(v0[j], 0.f), b = fmaxf(v1[j], 0.f); v0[j] = a * a; v1[j] = b * b; }
                    } else {
                        sq += (v0[0] * v0[0] + v0[1] * v0[1]) + (v0[2] * v0[2] + v0[3] * v0[3]) + (v1[0] * v1[0] + v1[1] * v1[1]) + (v1[2] * v1[2] + v1[3] * v1[3]);
                    }
                    u32x4 w; w.x = cvtpk(v0[0], v0[1]); w.y = cvtpk(v0[2], v0[3]); w.z = cvtpk(v1[0], v1[1]); w.w = cvtpk(v1[2], v1[3]);
                    if (bj == 0) store16_wt<0>(rowp, w); else store16_wt<HALF * 2>(rowp, w);
                }
                if (MODE == EM_Q || MODE == EM_KV) {
                    sq += __shfl_xor(sq, 16); sq += __shfl_xor(sq, 32);
                    if (fq == 0 && (MODE == EM_Q || u.pn < 4)) opart[(size_t)row * 16 + u.pn * 4 + wc] = sq;
                }
            }
    }
};
template <bool OUT_F32> struct EpiRes {
    static constexpr bool PERM = true;
    float* xout; bf16* xb; float* opart;
    __device__ __forceinline__ void operator()(const f32x4 (&acc)[2][2][4][2], const Unit& u, int wr, int wc, int fr, int fq) const {
        const int row0 = u.pm * BM + wr * 64 + fr, col0 = u.pn * BM + wc * 32 + 8 * fq;
        u32x4 xws[2][4][2];
#pragma unroll
        for (int ai = 0; ai < 2; ++ai)
#pragma unroll
            for (int m = 0; m < 4; ++m)
#pragma unroll
                for (int bj = 0; bj < 2; ++bj) xws[ai][m][bj] = *(const u32x4*)(xb + (size_t)(row0 + ai * HALF + m * 16) * DM + col0 + bj * HALF);
#pragma unroll
        for (int ai = 0; ai < 2; ++ai)
#pragma unroll
            for (int m = 0; m < 4; ++m) {
                const int row = row0 + ai * HALF + m * 16; const size_t off = (size_t)row * DM + col0; float sq = 0.f;
#pragma unroll
                for (int bj = 0; bj < 2; ++bj) {
                    const u32x4 xw = xws[ai][m][bj];
                    const f32x4 o0 = (f32x4){bflo(xw.x), bfhi(xw.x), bflo(xw.y), bfhi(xw.y)} + acc[ai][bj][m][0];
                    const f32x4 o1 = (f32x4){bflo(xw.z), bfhi(xw.z), bflo(xw.w), bfhi(xw.w)} + acc[ai][bj][m][1];
                    if (OUT_F32) { __builtin_nontemporal_store(o0, (f32x4*)(xout + off + bj * HALF)); __builtin_nontemporal_store(o1, (f32x4*)(xout + off + bj * HALF + 4)); }
                    u32x4 w; w.x = cvtpk(o0[0], o0[1]); w.y = cvtpk(o0[2], o0[3]); w.z = cvtpk(o1[0], o1[1]); w.w = cvtpk(o1[2], o1[3]);
                    if (bj == 0) store16_wt<0>(xb + off, w); else store16_wt<HALF * 2>(xb + off, w);
                    sq += ((o0[0] * o0[0] + o0[1] * o0[1]) + (o0[2] * o0[2] + o0[3] * o0[3])) + ((o1[0] * o1[0] + o1[1] * o1[1]) + (o1[2] * o1[2] + o1[3] * o1[3]));
                }
                sq += __shfl_xor(sq, 16); sq += __shfl_xor(sq, 32);
                if (fq == 0 && opart) unsafeAtomicAdd(opart + row, sq);
            }
    }
};

template <int HOOK = 0, bool PUB = false, class Epi, class Sched, bool ALIGN_EPI = true>
__device__ __forceinline__ void gemm_phase(LAS unsigned char* lds, const Gemm g, const Sched& S, const Epi& E) {
    const int tid = tid_opaque(), wid = __builtin_amdgcn_readfirstlane(tid >> 6), lane = tid & 63, wr = wid >> 2, wc = wid & 3, fr = lane & 15, fq = lane >> 4;
    const int K = g.K, nt = K / BK, lda = g.lda, tj = g.tj; const long ajump = g.ajump;
#define PG8_AO(tt) ((long)(tt) * (long)kstep + ((tt) >= tj ? ajump : 0l))
    unsigned voffA[2], voffB[2];
#pragma unroll
    for (int i = 0; i < 2; ++i) { int R, C; stage_rc(tid * 16 + i * 8192, R, C); const int Rb = Epi::PERM ? ((R & ~31) + perm32(R & 31)) : R;
        voffA[i] = (unsigned)(R * lda + C) * 2u; voffB[i] = (unsigned)(Rb * K + C) * 2u; }
    const size_t kstep = (size_t)(BK * 2);
    const size_t hstepA = (size_t)HALF * lda * 2, hstepB = (size_t)HALF * K * 2;
    const size_t tstepA = 2 * hstepA, tstepB = 2 * hstepB;
    const unsigned ldsw = (unsigned)wid * 1024u;
    const int aoff = lds_byte(wr * 64 + fr, fq * 8), boff = lds_byte(wc * 32 + fr, fq * 8);
#define PG8_SA(b, h) (((b) * 2 + (h)) * HTB)
#define PG8_SB(b, h) ((4 + (b) * 2 + (h)) * HTB)
#define PG8_STAGE(bufoff, gbase, voff) do { _Pragma("unroll") for (int _i = 0; _i < 2; ++_i) \
        __builtin_amdgcn_global_load_lds((const unsigned*)((const char*)(gbase) + (voff)[_i]), (LAS unsigned*)(lds + (bufoff) + ldsw + _i * 8192), 16, 0, 0); } while (0)
#define PG8_LDA(dst, b, h) do { _Pragma("unroll") for (int m = 0; m < 4; ++m) _Pragma("unroll") for (int k = 0; k < 2; ++k) dst[m][k] = *(const LAS bf16x8*)(lds + PG8_SA(b, h) + aoff + m * 2048 + k * 1024); } while (0)
#define PG8_LDB(dst, b, h) do { _Pragma("unroll") for (int n = 0; n < 2; ++n) _Pragma("unroll") for (int k = 0; k < 2; ++k) dst[n][k] = *(const LAS bf16x8*)(lds + PG8_SB(b, h) + boff + n * 2048 + k * 1024); } while (0)
#define PG8_MMA(ai, bj, At, Bt) do { __builtin_amdgcn_s_setprio(1); _Pragma("unroll") for (int m = 0; m < 4; ++m) _Pragma("unroll") for (int n = 0; n < 2; ++n) _Pragma("unroll") for (int k = 0; k < 2; ++k) \
        acc[ai][bj][m][n] = __builtin_amdgcn_mfma_f32_16x16x32_bf16(Bt[n][k], At[m][k], acc[ai][bj][m][n], 0, 0, 0); __builtin_amdgcn_s_setprio(0); } while (0)
#define PG8_WAIT_V(n) asm volatile("s_waitcnt vmcnt(" #n ")" ::: "memory")
#define PG8_WAIT_L(n) asm volatile("s_waitcnt lgkmcnt(" #n ")" ::: "memory")
#define PG8_BAR __builtin_amdgcn_s_barrier()
#define PG8_SCHED __builtin_amdgcn_sched_barrier(0)
    Unit cur, nxt; int ui = 0; int prev_pm = 0; (void)prev_pm;
    if (!S.next(0, cur)) return;
    f32x4 acc[2][2][4][2];
#pragma unroll
    for (int a = 0; a < 2; ++a)
#pragma unroll
        for (int b = 0; b < 2; ++b)
#pragma unroll
            for (int m = 0; m < 4; ++m)
#pragma unroll
                for (int n = 0; n < 2; ++n) acc[a][b][m][n] = (f32x4){0.f, 0.f, 0.f, 0.f};
    bf16x8 At[4][2], B0[2][2], B1[2][2];
    const char* cA = (const char*)g.A + (size_t)cur.pm * tstepA; const char* cB = (const char*)g.Bt + (size_t)cur.pn * tstepB;
    PG8_STAGE(PG8_SB(0, 0), cB, voffB); PG8_STAGE(PG8_SB(0, 1), cB + hstepB, voffB); PG8_STAGE(PG8_SA(0, 0), cA, voffA); PG8_STAGE(PG8_SA(0, 1), cA + hstepA, voffA);
    if (wr == 1) PG8_BAR;
    PG8_WAIT_V(2); PG8_BAR;
    PG8_STAGE(PG8_SB(1, 0), cB + kstep, voffB); PG8_STAGE(PG8_SA(1, 0), cA + kstep, voffA); PG8_STAGE(PG8_SB(1, 1), cB + hstepB + kstep, voffB);
    PG8_WAIT_V(6); PG8_BAR;
    for (;;) {
        const bool has_next = S.next(ui + 1, nxt);
        const char* nA = has_next ? (const char*)g.A + (size_t)nxt.pm * tstepA : cA; const char* nB = has_next ? (const char*)g.Bt + (size_t)nxt.pn * tstepB : cB;
        for (int t = 0; t < nt; t += 2) {
            const bool last = (t == nt - 2);
            const char* a1 = cA + PG8_AO(t + 1);
            const char* a2 = last ? nA : cA + PG8_AO(t + 2); const char* b2 = last ? nB : cB + (size_t)(t + 2) * kstep;
            const char* a3 = last ? nA + kstep : cA + PG8_AO(t + 3); const char* b3 = b2 + kstep;
            if constexpr (HOOK != 0) {
                if (t == tj) {
                    int fro = fr; asm volatile("" : "+v"(fro));
#pragma unroll
                    for (int ai = 0; ai < 2; ++ai)
#pragma unroll
                        for (int m = 0; m < 4; ++m) {
                            float rs;
                            if constexpr (HOOK == 2) rs = ((const LAS float*)(lds + MISC_OFF + 1024))[ai * HALF + wr * 64 + m * 16 + fro];
                            else { const int row = cur.pm * BM + ai * HALF + wr * 64 + m * 16 + fro;
                                const f32x4 s0 = *(const f32x4*)(g.hpart + (size_t)row * 8), s1 = *(const f32x4*)(g.hpart + (size_t)row * 8 + 4);
                                rs = rsqrtf((((s0[0] + s0[1]) + (s0[2] + s0[3])) + ((s1[0] + s1[1]) + (s1[2] + s1[3]))) * (1.0f / 512.0f) + EPS); }
#pragma unroll
                            for (int bj = 0; bj < 2; ++bj)
#pragma unroll
                                for (int n = 0; n < 2; ++n) acc[ai][bj][m][n] = acc[ai][bj][m][n] * rs;
                        }
                }
            }
            PG8_LDB(B0, 0, 0); PG8_LDB(B1, 0, 1); PG8_SCHED; PG8_LDA(At, 0, 0); PG8_STAGE(PG8_SA(1, 1), a1 + hstepA, voffA);
            PG8_WAIT_V(8); PG8_WAIT_L(0); PG8_BAR; PG8_MMA(0, 0, At, B0); PG8_MMA(0, 1, At, B1); PG8_BAR; PG8_SCHED;
            PG8_LDA(At, 0, 1); PG8_STAGE(PG8_SB(0, 0), b2, voffB); PG8_STAGE(PG8_SB(0, 1), b2 + hstepB, voffB); PG8_STAGE(PG8_SA(0, 0), a2, voffA);
            PG8_WAIT_V(8); PG8_WAIT_L(0); PG8_BAR; PG8_MMA(1, 0, At, B0); PG8_MMA(1, 1, At, B1); PG8_BAR; PG8_SCHED;
            PG8_LDB(B0, 1, 0); PG8_LDB(B1, 1, 1); PG8_SCHED; PG8_LDA(At, 1, 0); PG8_STAGE(PG8_SA(0, 1), a2 + hstepA, voffA);
            PG8_WAIT_V(8); PG8_WAIT_L(0); PG8_BAR; PG8_MMA(0, 0, At, B0); PG8_MMA(0, 1, At, B1); PG8_BAR; PG8_SCHED;
            PG8_LDA(At, 1, 1); PG8_STAGE(PG8_SB(1, 0), b3, voffB); PG8_STAGE(PG8_SB(1, 1), b3 + hstepB, voffB); PG8_STAGE(PG8_SA(1, 0), a3, voffA);
            PG8_WAIT_V(8); PG8_WAIT_L(0); PG8_BAR; PG8_MMA(1, 0, At, B0); PG8_MMA(1, 1, At, B1); PG8_BAR; PG8_SCHED;
        }
        if constexpr (ALIGN_EPI) { if (wr == 0) PG8_BAR; }
        E(acc, cur, wr, wc, fr, fq);
        if (!has_next) break;
#pragma unroll
        for (int a = 0; a < 2; ++a)
#pragma unroll
            for (int b = 0; b < 2; ++b)
#pragma unroll
                for (int m = 0; m < 4; ++m)
#pragma unroll
                    for (int n = 0; n < 2; ++n) acc[a][b][m][n] = (f32x4){0.f, 0.f, 0.f, 0.f};
        cur = nxt; cA = nA; cB = nB; ++ui;
        if constexpr (ALIGN_EPI) { if (wr == 1) PG8_BAR; }
    }
    PG8_WAIT_V(0);
    if constexpr (PUB) {
        Unit up; for (int i = 0; S.next(i, up); ++i) if (lane == 0) __hip_atomic_fetch_add(g.pub + 64 * up.pm, 1, __ATOMIC_RELAXED, __HIP_MEMORY_SCOPE_AGENT);
    }
    if constexpr (!ALIGN_EPI) { if (wr == 0) PG8_BAR; }
    PG8_BAR;
#undef PG8_AO
#undef PG8_SA
#undef PG8_SB
#undef PG8_STAGE
#undef PG8_LDA
#undef PG8_LDB
#undef PG8_MMA
#undef PG8_WAIT_V
#undef PG8_WAIT_L
#undef PG8_BAR
#undef PG8_SCHED
}
}

__device__ __forceinline__ void transpose_item(const float* W, int K, int N, bf16* WT, const float* g, bool permq, LAS float* scr, int item, int lane, int gk0 = 0, int krot = 0) {
    const int nblk = N / 64, kb = item / nblk, nb = item % nblk, k0 = 32 * kb, n0 = 64 * nb;
    const int kr = lane >> 4, nc = (lane & 15) * 4;
    f32x4 v[8];
#pragma unroll
    for (int i = 0; i < 8; ++i) v[i] = __builtin_nontemporal_load((const f32x4*)(W + (size_t)(k0 + 4 * i + kr) * N + n0 + nc));
    if (g && k0 >= gk0) {
#pragma unroll
        for (int i = 0; i < 8; ++i) v[i] = v[i] * g[k0 - gk0 + 4 * i + kr];
    }
#pragma unroll
    for (int i = 0; i < 8; ++i) { LAS float* d = scr + (4 * i + kr) * 66 + nc; *(LAS f32x2*)d = (f32x2){v[i][0], v[i][1]}; *(LAS f32x2*)(d + 2) = (f32x2){v[i][2], v[i][3]}; }
    asm volatile("s_waitcnt lgkmcnt(0)" ::: "memory");
    const int c = lane >> 4;
#pragma unroll
    for (int j = 0; j < 4; ++j) { const int n = (lane & 15) + 16 * j; const LAS float* s = scr + (8 * c) * 66 + n;
        u32x4 o; o.x = cvtpk(s[0 * 66], s[1 * 66]); o.y = cvtpk(s[2 * 66], s[3 * 66]); o.z = cvtpk(s[4 * 66], s[5 * 66]); o.w = cvtpk(s[6 * 66], s[7 * 66]);
        int nn = n0 + n;
        if (permq && nn < 1024) { const int hd = nn >> 7, i = nn & 127; nn = hd * 128 + (i < 64 ? 2 * i : 2 * (i - 64) + 1); }
        *(u32x4*)(WT + (size_t)nn * K + ((k0 + krot) & (K - 1)) + 8 * c) = o; }
    asm volatile("s_waitcnt lgkmcnt(0)" ::: "memory");
}
__device__ __forceinline__ void rows2_to_bf16(const float* xrow, bf16* orow, float* prow, int lane) {
    const f32x4* xr = (const f32x4*)xrow + lane;
    f32x4 v[8]; float s0 = 0.f, s1 = 0.f;
#pragma unroll
    for (int j = 0; j < 8; ++j) v[j] = __builtin_nontemporal_load(xr + 64 * j);
#pragma unroll
    for (int j = 0; j < 4; ++j) { s0 += (v[j][0] * v[j][0] + v[j][1] * v[j][1]) + (v[j][2] * v[j][2] + v[j][3] * v[j][3]); s1 += (v[j + 4][0] * v[j + 4][0] + v[j + 4][1] * v[j + 4][1]) + (v[j + 4][2] * v[j + 4][2] + v[j + 4][3] * v[j + 4][3]); }
#pragma unroll
    for (int o = 1; o < 64; o <<= 1) { s0 += __shfl_xor(s0, o); s1 += __shfl_xor(s1, o); }
    u32x2* o8 = (u32x2*)orow + lane;
#pragma unroll
    for (int j = 0; j < 8; ++j) { u32x2 w; w.x = cvtpk(v[j][0], v[j][1]); w.y = cvtpk(v[j][2], v[j][3]); o8[64 * j] = w; }
    if (lane < 2) prow[lane] = (lane == 0) ? s0 : s1;
}

#define MFMA32(a, b, c) __builtin_amdgcn_mfma_f32_32x32x16_bf16((a), (b), (c), 0, 0, 0)
typedef short v4i16_t __attribute__((ext_vector_type(4)));
__device__ __forceinline__ s16x4 vtr(const LAS unsigned char* p) { return __builtin_bit_cast(s16x4, __builtin_amdgcn_ds_read_tr16_b64_v4i16((LAS v4i16_t*)p)); }
#define PACK8(x, s) ((u32x4){cvtpk((x)[8 * (s)], (x)[8 * (s) + 1]), cvtpk((x)[8 * (s) + 2], (x)[8 * (s) + 3]), cvtpk((x)[8 * (s) + 4], (x)[8 * (s) + 5]), cvtpk((x)[8 * (s) + 6], (x)[8 * (s) + 7])})

template <bool MASK>
__device__ __forceinline__ void sb_block(f32x16& X, int kb, int t, int hi, float& carry) {
    float e[16], m[16];
#pragma unroll
    for (int r = 0; r < 16; ++r) {
        e[r] = __builtin_amdgcn_exp2f(fminf(X[r], 80.0f));
        m[r] = __builtin_amdgcn_rcpf(1.0f + e[r]);
        if (MASK) { if (!(kb + crow(r, hi) < t)) { m[r] = 1.0f; e[r] = 0.f; } }
    }
    float b[4], ob[4];
#pragma unroll
    for (int g = 0; g < 4; ++g) { b[g] = (m[4 * g] * m[4 * g + 1]) * (m[4 * g + 2] * m[4 * g + 3]); ob[g] = __shfl_xor(b[g], 32); }
    float run = carry;
#pragma unroll
    for (int g = 3; g >= 0; --g) {
        const float suf = (hi == 0) ? run * ob[g] : run;
        const float c3 = m[4 * g + 3] * suf, c2 = m[4 * g + 2] * c3, c1 = m[4 * g + 1] * c2, c0 = m[4 * g] * c1;
        X[4 * g + 3] = e[4 * g + 3] * c3; X[4 * g + 2] = e[4 * g + 2] * c2; X[4 * g + 1] = e[4 * g + 1] * c1; X[4 * g] = e[4 * g] * c0;
        run *= b[g] * ob[g];
    }
    carry = run;
}
__device__ __forceinline__ void ret_block(f32x16& X, int kb, int t, int hi, float lg2) {
#pragma unroll
    for (int r = 0; r < 16; ++r) { const float d = fabsf((float)(t - (kb + crow(r, hi)))); X[r] *= __builtin_amdgcn_exp2f(lg2 * d); }
}
__device__ __forceinline__ void ret_block_f(f32x16& X, float f, float g1, float g8) {
    float fj = f;
#pragma unroll
    for (int j = 0; j < 4; ++j) { float fi = fj;
#pragma unroll
        for (int i = 0; i < 4; ++i) { X[4 * j + i] *= fi; fi *= g1; }
        fj *= g8; }
}

__device__ __forceinline__ u32x4 widen_pair(u32x2 a, u32x2 b) {
    const auto s0 = __builtin_amdgcn_permlane32_swap(a.x, b.x, false, false);
    const auto s1 = __builtin_amdgcn_permlane32_swap(a.y, b.y, false, false);
    return (u32x4){s0[0], s1[0], s0[1], s1[1]};
}
__device__ __forceinline__ void glds16(const void* gsrc, unsigned lds_dst) { unsigned keep;
    asm volatile("s_mov_b32 %0, m0\n\ts_mov_b32 m0, %2\n\ts_nop 0\n\tglobal_load_lds_dwordx4 %1, off\n\ts_mov_b32 m0, %0" : "=&s"(keep) : "v"(gsrc), "s"(lds_dst) : "memory"); }

template <int HD, bool SB>
__device__ __forceinline__ void attn_unit(LAS unsigned char* lds, bf16* P, int b, int h, int qb, float lg2, const float* gret, float* sbpart) {
    constexpr int PITCH = INC, NS = HD / 16, ND = HD / 32, RB = HD * 2, NC = HD / 8, NC64 = HD / 32, KBYTES = 64 * RB;
    const int tid = tid_opaque(), lane = tid & 63, w = __builtin_amdgcn_readfirstlane(tid >> 6), r32 = lane & 31, hi = lane >> 5;
    const int qcol = SB ? 2048 + h * 64 : h * 128, kcol = SB ? 2560 + h * 64 : 512 + h * 128, vcol = SB ? 3072 + h * 64 : 1024 + h * 128;
    const size_t rowbase = (size_t)b * SEQ;
    const int q0 = qb * 256, tq = q0 + 32 * w + r32, wlo = q0 + 32 * w;
    bf16x8 qf[NS];
    { const bf16* qp = P + (rowbase + tq) * PITCH + qcol + hi * 8;
#pragma unroll
      for (int s = 0; s < NS; ++s) qf[s] = *(const bf16x8*)(qp + 16 * s); }
#pragma unroll
    for (int s = 0; s < NS; ++s) asm volatile("" : "+v"(qf[s]));
    f32x16 o[ND];
#pragma unroll
    for (int d = 0; d < ND; ++d)
#pragma unroll
        for (int r = 0; r < 16; ++r) o[d][r] = 0.f;
    float carry = SB ? 1.0f : 0.f;
    float g1 = 1.f, g8 = 1.f, c32 = 1.f;
    if (!SB) { g1 = __builtin_amdgcn_exp2f(-lg2); g8 = __builtin_amdgcn_exp2f(-8.0f * lg2); c32 = __builtin_amdgcn_exp2f(-32.0f * lg2); }
    const int NT = 4 * (qb + 1);
    constexpr int TILEB = 2 * KBYTES, PIECES = TILEB / 1024, PPW = PIECES / 8, RPP = 1024 / RB;
    const int rip = lane / NC, pos = lane % NC;
    const unsigned lds0 = (unsigned)(uintptr_t)lds;
#define AT_DMA(kt, slot) do { _Pragma("unroll") for (int i_ = 0; i_ < PPW; ++i_) { const int pc_ = w * PPW + i_, mat_ = pc_ / (PIECES / 2), pim_ = pc_ % (PIECES / 2), row_ = pim_ * RPP + rip; \
        const int c_ = mat_ ? ((((pos >> 2) ^ (row_ & (NC64 - 1))) << 2) | (pos & 3)) : (pos ^ (row_ & (NC - 1))); \
        glds16(P + (rowbase + 64 * (kt) + row_) * PITCH + (mat_ ? vcol : kcol) + 8 * c_, (unsigned)__builtin_amdgcn_readfirstlane((int)(lds0 + (slot) * TILEB + mat_ * KBYTES + pim_ * 1024))); } } while (0)
    __syncthreads();
#define AT_TILE(j) (SB ? NT - 1 - (j) : (j))
    AT_DMA(AT_TILE(0), 0); AT_DMA(AT_TILE(1), 1); AT_DMA(AT_TILE(2), 2);
    int cur = 0;
    const int blk = (lane >> 4) & 1, p4 = lane & 3, q4 = (lane & 15) >> 2;
    volatile LAS int* flg = (volatile LAS int*)(lds + MISC_OFF + 64);
    bool wdone = false;
    for (int j = 0; j < NT; ++j, cur = (cur + 1) & 3) {
        const int kt = AT_TILE(j);
        if (j + 2 < NT) { if (PPW == 2) asm volatile("s_waitcnt vmcnt(4)" ::: "memory"); else asm volatile("s_waitcnt vmcnt(8)" ::: "memory"); }
        else if (j + 1 < NT) { if (PPW == 2) asm volatile("s_waitcnt vmcnt(2)" ::: "memory"); else asm volatile("s_waitcnt vmcnt(4)" ::: "memory"); }
        else asm volatile("s_waitcnt vmcnt(0)" ::: "memory");
        if (SB && lane == 0) flg[(kt & 1) * 8 + w] = wdone ? 1 : 0;
        __syncthreads();
        if (SB) { const LAS int* f4 = (const LAS int*)(lds + MISC_OFF + 64 + (kt & 1) * 32); const int a0 = f4[0] & f4[1] & f4[2] & f4[3] & f4[4] & f4[5] & f4[6] & f4[7]; if (a0) break; }
        if (j + 3 < NT) AT_DMA(AT_TILE(j + 3), (cur + 3) & 3);
        const bool part = SB ? (64 * kt < wlo + 31 && !wdone) : (kt <= (wlo >> 6));
        if (part) {
            const LAS unsigned char* Kb = lds + cur * TILEB; const LAS unsigned char* Vb = Kb + KBYTES;
            f32x16 p0, p1;
#pragma unroll
            for (int r = 0; r < 16; ++r) { p0[r] = 0.f; p1[r] = 0.f; }
#pragma unroll
            for (int sb = 0; sb < NS / 4; ++sb) {
                bf16x8 kf0[4], kf1[4];
#pragma unroll
                for (int i = 0; i < 4; ++i) { const int c = 2 * (4 * sb + i) + hi;
                    kf0[i] = *(const LAS bf16x8*)(Kb + r32 * RB + ((c ^ (r32 & (NC - 1))) << 4));
                    kf1[i] = *(const LAS bf16x8*)(Kb + (32 + r32) * RB + ((c ^ (r32 & (NC - 1))) << 4)); }
                __builtin_amdgcn_sched_barrier(0);
#pragma unroll
                for (int i = 0; i < 4; ++i) { p0 = MFMA32(kf0[i], qf[4 * sb + i], p0); p1 = MFMA32(kf1[i], qf[4 * sb + i], p1); }
                __builtin_amdgcn_sched_barrier(0);
            }
            s16x4 vl[ND][4], vh[ND][4];
            if (SB) {
#pragma unroll
                for (int d0 = 0; d0 < ND; ++d0)
#pragma unroll
                    for (int ks = 0; ks < 4; ++ks) { const int rowA = 16 * ks + 4 * hi + q4, rowB = rowA + 8;
                        vl[d0][ks] = vtr(Vb + rowA * RB + ((d0 ^ (rowA & (NC64 - 1))) << 6) + 32 * blk + 8 * p4);
                        vh[d0][ks] = vtr(Vb + rowB * RB + ((d0 ^ (rowB & (NC64 - 1))) << 6) + 32 * blk + 8 * p4); }
                __builtin_amdgcn_sched_barrier(0);
            }
            if (SB) {
                if (64 * kt + 63 < wlo) { sb_block<false>(p1, 64 * kt + 32, tq, hi, carry); sb_block<false>(p0, 64 * kt, tq, hi, carry); }
                else { sb_block<true>(p1, 64 * kt + 32, tq, hi, carry); sb_block<true>(p0, 64 * kt, tq, hi, carry); }
                wdone = __all(carry < 1e-37f) != 0;
            } else if (kt == (wlo >> 6)) { ret_block(p1, 64 * kt + 32, tq, hi, lg2); ret_block(p0, 64 * kt, tq, hi, lg2); }
            else { const float f0 = __builtin_amdgcn_exp2f(lg2 * (float)(tq - 64 * kt - 4 * hi)); ret_block_f(p0, f0, g1, g8); ret_block_f(p1, f0 * c32, g1, g8); }
            bf16x8 pa[4];
            pa[0] = __builtin_bit_cast(bf16x8, PACK8(p0, 0)); pa[1] = __builtin_bit_cast(bf16x8, PACK8(p0, 1));
            pa[2] = __builtin_bit_cast(bf16x8, PACK8(p1, 0)); pa[3] = __builtin_bit_cast(bf16x8, PACK8(p1, 1));
#pragma unroll
            for (int ks = 0; ks < 4; ++ks) {
                if (!SB) {
                    const int rowA = 16 * ks + 4 * hi + q4, rowB = rowA + 8;
#pragma unroll
                    for (int d0 = 0; d0 < ND; ++d0) {
                        vl[d0][ks] = vtr(Vb + rowA * RB + ((d0 ^ (rowA & (NC64 - 1))) << 6) + 32 * blk + 8 * p4);
                        vh[d0][ks] = vtr(Vb + rowB * RB + ((d0 ^ (rowB & (NC64 - 1))) << 6) + 32 * blk + 8 * p4); }
                    __builtin_amdgcn_sched_barrier(0);
                }
#pragma unroll
                for (int d0 = 0; d0 < ND; ++d0) {
                    const bf16x8 vf = __builtin_shufflevector(vl[d0][ks], vh[d0][ks], 0, 1, 2, 3, 4, 5, 6, 7);
                    o[d0] = MFMA32(vf, pa[ks], o[d0]);
                }
                if (!SB) __builtin_amdgcn_sched_barrier(0);
            }
        }
    }
#undef AT_DMA
#undef AT_TILE
    asm volatile("s_waitcnt vmcnt(0)" ::: "memory");
    bf16* orow = P + (rowbase + wlo + r32) * PITCH + qcol + 4 * hi;
    float ss = 0.f;
#pragma unroll
    for (int d0 = 0; d0 < ND; ++d0)
#pragma unroll
        for (int r = 0; r < 16; ++r) ss += o[d0][r] * o[d0][r];
    ss += __shfl_xor(ss, 32);
    if (SB) {
        if (hi == 0) sbpart[(rowbase + wlo + r32) * 8 + h] = ss;
#pragma unroll
        for (int d0 = 0; d0 < ND; ++d0)
#pragma unroll
            for (int k = 0; k < 2; ++k) { u32x2 wa, wb; wa.x = cvtpk(o[d0][8 * k], o[d0][8 * k + 1]); wa.y = cvtpk(o[d0][8 * k + 2], o[d0][8 * k + 3]); wb.x = cvtpk(o[d0][8 * k + 4], o[d0][8 * k + 5]); wb.y = cvtpk(o[d0][8 * k + 6], o[d0][8 * k + 7]);
                *(u32x4*)(orow + 32 * d0 + 16 * k + 4 * hi) = widen_pair(wa, wb); }
    } else {
        const float rs = rsqrtf(ss * (1.0f / 128.0f) + EPS);
        u32x2 gt[ND][4]; f32x4 gr[ND][4];
#pragma unroll
        for (int d0 = 0; d0 < ND; ++d0)
#pragma unroll
            for (int k = 0; k < 2; ++k) {
                const u32x4 L = *(const u32x4*)(orow + 1536 + 32 * d0 + 16 * k + 4 * hi);
                const auto s0 = __builtin_amdgcn_permlane32_swap(L.x, L.z, false, false); const auto s1 = __builtin_amdgcn_permlane32_swap(L.y, L.w, false, false);
                gt[d0][2 * k] = (u32x2){s0[0], s1[0]}; gt[d0][2 * k + 1] = (u32x2){s0[1], s1[1]};
                gr[d0][2 * k] = *(const f32x4*)(gret + h * 128 + 32 * d0 + 16 * k + 4 * hi); gr[d0][2 * k + 1] = *(const f32x4*)(gret + h * 128 + 32 * d0 + 16 * k + 8 + 4 * hi); }
#pragma unroll
        for (int d0 = 0; d0 < ND; ++d0)
#pragma unroll
            for (int k = 0; k < 2; ++k) {
                u32x2 wv[2];
#pragma unroll
                for (int gi = 0; gi < 2; ++gi) { const int g = 2 * k + gi; const f32x4 gg = gr[d0][g] * rs;
                    wv[gi].x = cvtpk(o[d0][4 * g] * gg[0] * bflo(gt[d0][g].x), o[d0][4 * g + 1] * gg[1] * bfhi(gt[d0][g].x));
                    wv[gi].y = cvtpk(o[d0][4 * g + 2] * gg[2] * bflo(gt[d0][g].y), o[d0][4 * g + 3] * gg[3] * bfhi(gt[d0][g].y)); }
                *(u32x4*)(orow + 32 * d0 + 16 * k + 4 * hi) = widen_pair(wv[0], wv[1]);
            }
    }
}

__device__ __forceinline__ void sb_unit(LAS unsigned char* lds, bf16* P, int b, int h, int qb, float* sbpart) {
    constexpr int PITCH = INC, NS = 4, ND = 2, RB = 128;
    const int tid = tid_opaque(), lane = tid & 63, w = __builtin_amdgcn_readfirstlane(tid >> 6), r32 = lane & 31, hi = lane >> 5;
    const int qcol = 2048 + h * 64, kcol = 2560 + h * 64, vcol = 3072 + h * 64;
    const size_t rowbase = (size_t)b * SEQ;
    const int q0 = qb * 256, wlo = q0 + 32 * w, tq = wlo + r32;
    bf16x8 qf[NS];
    { const bf16* qp = P + (rowbase + tq) * PITCH + qcol + hi * 8;
#pragma unroll
      for (int s = 0; s < NS; ++s) qf[s] = *(const bf16x8*)(qp + 16 * s); }
#pragma unroll
    for (int s = 0; s < NS; ++s) asm volatile("" : "+v"(qf[s]));
    f32x16 o[ND];
#pragma unroll
    for (int d = 0; d < ND; ++d)
#pragma unroll
        for (int r = 0; r < 16; ++r) o[d][r] = 0.f;
    float carry = 1.0f;
    const unsigned wbase = (unsigned)(uintptr_t)lds + (unsigned)w * 16384u;
    const LAS unsigned char* wl = lds + w * 16384;
    const int rip = lane >> 3, pos = lane & 7;
#define SB_DMA(hb, slot) do { _Pragma("unroll") for (int pc_ = 0; pc_ < 8; ++pc_) { const int mat_ = pc_ >> 2, row_ = 8 * (pc_ & 3) + rip; \
        const int c_ = mat_ ? ((((pos >> 2) ^ (row_ & 1)) << 2) | (pos & 3)) : (pos ^ (row_ & 7)); \
        glds16(P + (rowbase + 32 * (hb) + row_) * PITCH + (mat_ ? vcol : kcol) + 8 * c_, (unsigned)__builtin_amdgcn_readfirstlane((int)(wbase + (slot) * 8192 + mat_ * 4096 + (pc_ & 3) * 1024))); } } while (0)
    const int hb0 = wlo >> 5;
    __syncthreads();
    SB_DMA(hb0, 0);
    const int blk = (lane >> 4) & 1, p4 = lane & 3, q4 = (lane & 15) >> 2;
    int sl = 0;
    for (int hb = hb0; hb >= 0; --hb, sl ^= 1) {
        if (hb > 0) { SB_DMA(hb - 1, sl ^ 1); asm volatile("s_waitcnt vmcnt(8)" ::: "memory"); }
        else asm volatile("s_waitcnt vmcnt(0)" ::: "memory");
        const LAS unsigned char* Kb = wl + sl * 8192; const LAS unsigned char* Vb = Kb + 4096;
        f32x16 p;
#pragma unroll
        for (int r = 0; r < 16; ++r) p[r] = 0.f;
        bf16x8 kf[NS];
#pragma unroll
        for (int s = 0; s < NS; ++s) kf[s] = *(const LAS bf16x8*)(Kb + r32 * RB + (((2 * s + hi) ^ (r32 & 7)) << 4));
        s16x4 vl[ND][2], vh[ND][2];
#pragma unroll
        for (int d0 = 0; d0 < ND; ++d0)
#pragma unroll
            for (int ks = 0; ks < 2; ++ks) { const int rowA = 16 * ks + 4 * hi + q4, rowB = rowA + 8;
                vl[d0][ks] = vtr(Vb + rowA * RB + ((d0 ^ (rowA & 1)) << 6) + 32 * blk + 8 * p4);
                vh[d0][ks] = vtr(Vb + rowB * RB + ((d0 ^ (rowB & 1)) << 6) + 32 * blk + 8 * p4); }
#pragma unroll
        for (int s = 0; s < NS; ++s) p = MFMA32(kf[s], qf[s], p);
        if (32 * hb + 31 < wlo) sb_block<false>(p, 32 * hb, tq, hi, carry); else sb_block<true>(p, 32 * hb, tq, hi, carry);
        bf16x8 pa[2];
        pa[0] = __builtin_bit_cast(bf16x8, PACK8(p, 0)); pa[1] = __builtin_bit_cast(bf16x8, PACK8(p, 1));
#pragma unroll
        for (int ks = 0; ks < 2; ++ks)
#pragma unroll
            for (int d0 = 0; d0 < ND; ++d0) {
                const bf16x8 vf = __builtin_shufflevector(vl[d0][ks], vh[d0][ks], 0, 1, 2, 3, 4, 5, 6, 7);
                o[d0] = MFMA32(vf, pa[ks], o[d0]);
            }
        if (__all(carry < 1e-37f)) break;
    }
#undef SB_DMA
    asm volatile("s_waitcnt vmcnt(0)" ::: "memory");
    bf16* orow = P + (rowbase + wlo + r32) * PITCH + qcol + 4 * hi;
    float ss = 0.f;
#pragma unroll
    for (int d0 = 0; d0 < ND; ++d0)
#pragma unroll
        for (int r = 0; r < 16; ++r) ss += o[d0][r] * o[d0][r];
    ss += __shfl_xor(ss, 32);
    if (hi == 0) sbpart[(rowbase + wlo + r32) * 8 + h] = ss;
#pragma unroll
    for (int d0 = 0; d0 < ND; ++d0)
#pragma unroll
        for (int k = 0; k < 2; ++k) { u32x2 wa, wb; wa.x = cvtpk(o[d0][8 * k], o[d0][8 * k + 1]); wa.y = cvtpk(o[d0][8 * k + 2], o[d0][8 * k + 3]); wb.x = cvtpk(o[d0][8 * k + 4], o[d0][8 * k + 5]); wb.y = cvtpk(o[d0][8 * k + 6], o[d0][8 * k + 7]);
            *(u32x4*)(orow + 32 * d0 + 16 * k + 4 * hi) = widen_pair(wa, wb); }
}

__device__ __forceinline__ void xattn_unit(LAS unsigned char* lds, const bf16* Q, const bf16* KV, const float* qpart, bf16* O, int b, int h, int tb) {
    const int tid = tid_opaque(), lane = tid & 63, w = __builtin_amdgcn_readfirstlane(tid >> 6), r32 = lane & 31, hi = lane >> 5;
    const size_t Rw = (size_t)b * SEQ + tb * 256 + 32 * w, R = Rw + r32;
    const bf16* kvb = KV + (size_t)b * NMEM * 2048 + h * 256;
    const unsigned ldsb = (unsigned)(uintptr_t)lds; const int rip = lane >> 5, pos = lane & 31;
    __syncthreads();
#pragma unroll
    for (int i = 0; i < 16; ++i) { const int pim = w * 16 + i, row = 2 * pim + rip, c = pos ^ (row & 31);
        glds16(kvb + (size_t)row * 2048 + c * 8, (unsigned)__builtin_amdgcn_readfirstlane((int)(ldsb + pim * 1024))); }
    asm volatile("s_waitcnt vmcnt(0)" ::: "memory");
    __syncthreads();
    const bf16* qp = Q + R * DM + h * 256 + hi * 8;
    const f32x4 qq = *(const f32x4*)(qpart + R * 16 + h * 4);
    const float rq = rsqrtf(((qq[0] + qq[1]) + (qq[2] + qq[3])) * (1.0f / 256.0f) + EPS);
    float l = 0.f; bf16x8 pa[8][2];
#pragma unroll
    for (int half = 0; half < 2; ++half) {
        f32x16 p[4];
#pragma unroll
        for (int kb = 0; kb < 4; ++kb)
#pragma unroll
            for (int r = 0; r < 16; ++r) p[kb][r] = 0.f;
#pragma unroll
        for (int s = 0; s < 16; ++s) {
            const bf16x8 qf = *(const bf16x8*)(qp + 16 * s); const int c = 2 * s + hi;
#pragma unroll
            for (int kb = 0; kb < 4; ++kb) { const bf16x8 kf = *(const LAS bf16x8*)(lds + (128 * half + 32 * kb + r32) * 512 + ((c ^ r32) << 4)); p[kb] = MFMA32(kf, qf, p[kb]); }
        }
        if (half == 1) {
            asm volatile("s_waitcnt lgkmcnt(0)" ::: "memory");
            __syncthreads();
#pragma unroll
            for (int i = 0; i < 16; ++i) { const int pim = w * 16 + i, row = 2 * pim + rip, c = (((pos >> 2) ^ (row & 7)) << 2) | (pos & 3);
                glds16(kvb + 1024 + (size_t)row * 2048 + c * 8, (unsigned)__builtin_amdgcn_readfirstlane((int)(ldsb + pim * 1024))); __builtin_amdgcn_sched_barrier(0); }
        }
#pragma unroll
        for (int kb = 0; kb < 4; ++kb) {
#pragma unroll
            for (int r = 0; r < 16; ++r) { const float e = __builtin_amdgcn_exp2f(p[kb][r] * rq); l += e; p[kb][r] = e; }
            pa[4 * half + kb][0] = __builtin_bit_cast(bf16x8, PACK8(p[kb], 0)); pa[4 * half + kb][1] = __builtin_bit_cast(bf16x8, PACK8(p[kb], 1));
        }
    }
    l += __shfl_xor(l, 32);
    const float rl = 1.0f / l;
    asm volatile("s_waitcnt vmcnt(0)" ::: "memory");
    __syncthreads();
    const int blk = (lane >> 4) & 1, p4 = lane & 3, q4 = (lane & 15) >> 2;
    bf16* op = O + R * DM + h * 256 + 4 * hi;
#pragma unroll
    for (int dp = 0; dp < 4; ++dp) {
        f32x16 oa[2], ob[2];
#pragma unroll
        for (int e = 0; e < 2; ++e)
#pragma unroll
            for (int r = 0; r < 16; ++r) { oa[e][r] = 0.f; ob[e][r] = 0.f; }
#pragma unroll
        for (int ks = 0; ks < 16; ks += 2) {
            s16x4 lo[2][2], hh[2][2];
#pragma unroll
            for (int kk = 0; kk < 2; ++kk) { const int rowA = 16 * (ks + kk) + 4 * hi + q4, rowB = rowA + 8;
#pragma unroll
                for (int e = 0; e < 2; ++e) { const int d0 = 2 * dp + e;
                    lo[kk][e] = vtr(lds + rowA * 512 + ((d0 ^ (rowA & 7)) << 6) + 32 * blk + 8 * p4);
                    hh[kk][e] = vtr(lds + rowB * 512 + ((d0 ^ (rowB & 7)) << 6) + 32 * blk + 8 * p4); } }
#pragma unroll
            for (int e = 0; e < 2; ++e) {
                oa[e] = MFMA32(__builtin_shufflevector(lo[0][e], hh[0][e], 0, 1, 2, 3, 4, 5, 6, 7), pa[ks >> 1][0], oa[e]);
                ob[e] = MFMA32(__builtin_shufflevector(lo[1][e], hh[1][e], 0, 1, 2, 3, 4, 5, 6, 7), pa[ks >> 1][1], ob[e]);
            }
        }
#pragma unroll
        for (int e = 0; e < 2; ++e)
#pragma unroll
            for (int k = 0; k < 2; ++k) {
                u32x2 wv[2];
#pragma unroll
                for (int gi = 0; gi < 2; ++gi) { const int g = 2 * k + gi;
                    wv[gi].x = cvtpk((oa[e][4 * g] + ob[e][4 * g]) * rl, (oa[e][4 * g + 1] + ob[e][4 * g + 1]) * rl); wv[gi].y = cvtpk((oa[e][4 * g + 2] + ob[e][4 * g + 2]) * rl, (oa[e][4 * g + 3] + ob[e][4 * g + 3]) * rl); }
                *(u32x4*)(op + 32 * (2 * dp + e) + 16 * k + 4 * hi) = widen_pair(wv[0], wv[1]); }
    }
}

#define XB_TMO      128
#define XB_XCNT(j)  (256  + 64 * (j))
#define XB_XSUB(j)  (1280 + 64 * (j))
#define XB_XGEN(j)  (2304 + 64 * (j))
#define XB_TOP      3328
#define XB_TOPGEN   3392
#define XCD_BAR_WORDS 3456
#define XB_SPIN_CAP (1u << 18)

__device__ __forceinline__ unsigned xb_ld(unsigned* p)              { return __hip_atomic_load(p, __ATOMIC_RELAXED, __HIP_MEMORY_SCOPE_AGENT); }
__device__ __forceinline__ unsigned xb_add(unsigned* p, unsigned v) { return __hip_atomic_fetch_add(p, v, __ATOMIC_RELAXED, __HIP_MEMORY_SCOPE_AGENT); }
__device__ __forceinline__ unsigned xb_xcc_id() { return (unsigned)__builtin_amdgcn_s_getreg((3 << 11) | 20) & 0xFu; }
#define XB_SPIN(cond, bar) do { unsigned _sp = 0; while (cond) { __builtin_amdgcn_s_sleep(1); \
    if ((++_sp & 255u) == 0u) { if (xb_ld(&(bar)[XB_TMO])) break; if (_sp > XB_SPIN_CAP) { atomicAdd(&(bar)[XB_TMO], 1u); break; } } } } while (0)

struct XcdBarrier {
    unsigned* bar; unsigned x;
    volatile LAS unsigned* st;
};

__device__ __forceinline__ XcdBarrier xcd_barrier_post(unsigned* bar, volatile LAS unsigned* st) {
    XcdBarrier b; b.bar = bar; b.x = xb_xcc_id(); b.st = st;
    if (threadIdx.x == 0) (void)xb_add(&bar[XB_XCNT(b.x)], 1u);
    return b;
}
__device__ __forceinline__ void xcd_barrier_complete(unsigned* bar, unsigned x, unsigned& nloc, unsigned& nx) {
    const unsigned G = gridDim.x * gridDim.y * gridDim.z;
    unsigned sum, cnt, mine, sp = 0u;
    for (;;) {
        sum = 0u; cnt = 0u; mine = 0u;
#pragma unroll
        for (unsigned j = 0; j < 16; ++j) { const unsigned c = xb_ld(&bar[XB_XCNT(j)]); sum += c; cnt += (c > 0u) ? 1u : 0u; mine = (j == x) ? c : mine; }
        if (sum == G) break;
        __builtin_amdgcn_s_sleep(1);
        if ((++sp & 255u) == 0u) { if (xb_ld(&bar[XB_TMO])) break; if (sp > XB_SPIN_CAP) { atomicAdd(&bar[XB_TMO], 1u); break; } }
    }
    nloc = mine > 0u ? mine : 1u; nx = cnt > 0u ? cnt : 1u;
}

__device__ __forceinline__ void xcd_barrier(const XcdBarrier& b) {
    asm volatile("s_waitcnt vmcnt(0)" ::: "memory");
    __syncthreads();
    if (threadIdx.x == 0) {
        unsigned* bar = b.bar;
        __builtin_amdgcn_s_waitcnt(0);
        unsigned nloc = b.st[0], nx = b.st[1];
        if (nloc == 0u) { xcd_barrier_complete(bar, b.x, nloc, nx); b.st[0] = nloc; b.st[1] = nx; }
        const unsigned old = xb_add(&bar[XB_XSUB(b.x)], 1u);
        const unsigned gen = old / nloc;
        if (old + 1u == (gen + 1u) * nloc) {
            __builtin_amdgcn_fence(__ATOMIC_RELEASE, "agent");
            asm volatile("s_waitcnt vmcnt(0)" ::: "memory");
            const unsigned og = xb_add(&bar[XB_TOP], 1u);
            const unsigned tg = og / nx;
            if (og + 1u == (tg + 1u) * nx) xb_add(&bar[XB_TOPGEN], 1u);
            else XB_SPIN(xb_ld(&bar[XB_TOPGEN]) == tg, bar);
            __builtin_amdgcn_fence(__ATOMIC_ACQUIRE, "agent");
            xb_add(&bar[XB_XGEN(b.x)], 1u);
            asm volatile("s_waitcnt vmcnt(0)" ::: "memory");
        } else {
            XB_SPIN(xb_ld(&bar[XB_XGEN(b.x)]) == gen, bar);
            __builtin_amdgcn_fence(__ATOMIC_ACQUIRE, "agent");
            asm volatile("s_waitcnt vmcnt(0)" ::: "memory");
        }
    }
    __syncthreads();
}

struct Args { const float* in[17]; float* out; unsigned char* ws; };
typedef const __attribute__((address_space(4))) Args* cargs_t;
__device__ __forceinline__ cargs_t get_args() { cargs_t p = (cargs_t)__builtin_amdgcn_kernarg_segment_ptr(); asm volatile("" : "+s"(p)); return p; }
#define PHASE_VARS cargs_t A = get_args(); unsigned char* ws = A->ws; const int tid = tid_opaque(), lane = tid & 63, wave = __builtin_amdgcn_readfirstlane(tid >> 6), G = gridDim.x, bx = blockIdx.x, gw = bx * 8 + wave, NGW = G * 8; (void)lane; (void)gw; (void)NGW; (void)ws
#define P_XB ((bf16*)(ws + WS_XB))
#define P_R1 ((bf16*)(ws + WS_R1))
#define P_O ((bf16*)(ws + WS_O))
#define P_KV ((bf16*)(ws + WS_KV))
#define P_MEMB ((bf16*)(ws + WS_MEMB))
#define P_XSS(slot) ((float*)(ws + WS_XSS) + (size_t)(slot) * T_TOK)
#define P_QPART ((float*)(ws + WS_QPART))
#define P_KPART ((float*)(ws + WS_KPART))
#define P_MSS ((float*)(ws + WS_MSS))
#define P_CTR ((int*)(ws + WS_CTR))
#define P_WL(l) ((const bf16*)(ws + WS_W + (size_t)(l) * W_LAYER))

__global__ void __launch_bounds__(512, 2) hymba_fwd(Args a_unused) {
    extern __shared__ __attribute__((aligned(16))) unsigned char lds_raw[];
    LAS unsigned char* lds = (LAS unsigned char*)lds_raw;
    cg::grid_group grid = cg::this_grid();
    if (threadIdx.x < 8) ((volatile LAS unsigned*)(lds + MISC_OFF + 128))[threadIdx.x] = 0u;
    __syncthreads();
    { cargs_t A0 = get_args(); (void)xcd_barrier_post((unsigned*)(A0->ws + WS_BAR), (volatile LAS unsigned*)(lds + MISC_OFF + 128)); }
    if (gridDim.x == 0x7fffffffu) grid.sync();
#define GRID_SYNC() do { XcdBarrier b_; b_.bar = (unsigned*)(get_args()->ws + WS_BAR); b_.x = xb_xcc_id(); b_.st = (volatile LAS unsigned*)(lds + MISC_OFF + 128); xcd_barrier(b_); } while (0)

    {
        PHASE_VARS;
        LAS float* scr = (LAS float*)(lds + wave * 16384);
        constexpr int I_IN = 32 * (INC / 64), I_SQ = 32 * 16, I_KV = 32 * 32, I_UP = 32 * 64, I_DN = 128 * 16;
        constexpr int PER_LAYER = I_IN + 3 * I_SQ + I_KV + I_UP + I_DN;
        for (int it = gw; it < 2 * PER_LAYER; it += NGW) {
            const int itr = 2 * PER_LAYER - 1 - it;
            const int l = itr / PER_LAYER; int r = itr % PER_LAYER;
            bf16* wl = (bf16*)(ws + WS_W + (size_t)l * W_LAYER);
            if (r < I_IN) { transpose_item(A->in[3] + (size_t)l * DM * INC, DM, INC, wl + WO_IN / 2, A->in[2] + l * DM, true, scr, r, lane); continue; } r -= I_IN;
            if (r < I_SQ) { transpose_item(A->in[6] + (size_t)l * DM * DM, DM, DM, wl + WO_MIX / 2, A->in[5] + l * 512, false, scr, r, lane, 512, 512); continue; } r -= I_SQ;
            if (r < I_SQ) { transpose_item(A->in[9] + (size_t)l * DM * DM, DM, DM, wl + WO_XQ / 2, A->in[7] + l * DM, false, scr, r, lane); continue; } r -= I_SQ;
            if (r < I_KV) { transpose_item(A->in[10] + (size_t)l * DM * 2048, DM, 2048, wl + WO_XKV / 2, A->in[8] + l * DM, false, scr, r, lane); continue; } r -= I_KV;
            if (r < I_SQ) { transpose_item(A->in[13] + (size_t)l * DM * DM, DM, DM, wl + WO_XO / 2, nullptr, false, scr, r, lane); continue; } r -= I_SQ;
            if (r < I_UP) { transpose_item(A->in[15] + (size_t)l * DM * FF, DM, FF, wl + WO_UP / 2, A->in[14] + l * DM, false, scr, r, lane); continue; } r -= I_UP;
            transpose_item(A->in[16] + (size_t)l * FF * DM, FF, DM, wl + WO_DOWN / 2, nullptr, false, scr, r, lane);
        }
        const float* x_in = A->in[0]; const float* mem = A->in[1];
        for (int m = 2 * gw; m < T_TOK; m += 2 * NGW) rows2_to_bf16(x_in + (size_t)m * DM, P_XB + (size_t)m * DM, P_XSS(0) + m, lane);
        for (int m = 2 * gw; m < MROWS; m += 2 * NGW) rows2_to_bf16(mem + (size_t)m * DM, P_MEMB + (size_t)m * DM, P_MSS + m, lane);
        if (bx == 0 && tid < 16) P_CTR[tid] = 0;
    }
    GRID_SYNC();

    for (int l = 0; l < 2; ++l) {
        asm volatile("" : "+s"(l));
        {
            PHASE_VARS;
            pg8::Gemm g{P_XB, P_WL(l) + WO_IN / 2, T_TOK, INC, DM, DM, 1 << 30, 0l, nullptr}; pg8::StaticOrder S; S.init(T_TOK, INC, G, bx);
            pg8::EpiB<pg8::EM_PROJ> E{P_R1, INC, P_XSS(3 * l), nullptr};
            pg8::gemm_phase(lds, g, S, E);
        }
        {
            PHASE_VARS;
            pg8::Gemm g2{P_MEMB, P_WL(l) + WO_XKV / 2, MROWS, 2048, DM, DM, 1 << 30, 0l, nullptr}; pg8::StaticOrder S2; S2.init(MROWS, 2048, G, G - 1 - bx);
            pg8::EpiB<pg8::EM_KV> E2{P_KV, 2048, P_MSS, P_KPART};
            pg8::gemm_phase(lds, g2, S2, E2);
        }
        GRID_SYNC();
        {
            PHASE_VARS;
            const float* gqn = A->in[11] + l * 256; const float* gkn = A->in[12] + l * 256;
            bf16* kv = P_KV; const float* kpart = P_KPART;
            for (int it = gw; it < MROWS * 4; it += NGW) {
                const int row = it >> 2, hh = it & 3;
                const f32x4 kp = *(const f32x4*)(kpart + (size_t)row * 16 + hh * 4);
                const float rk = rsqrtf(((kp[0] + kp[1]) + (kp[2] + kp[3])) * (1.0f / 256.0f) + EPS) * (0.0625f * 1.4426950408889634f);
                u32x2* p = (u32x2*)(kv + (size_t)row * 2048 + hh * 256) + lane;
                const u32x2 v = *p; const f32x4 g1 = *((const f32x4*)gqn + lane), g2 = *((const f32x4*)gkn + lane);
                u32x2 o; o.x = cvtpk(bflo(v.x) * rk * g1[0] * g2[0], bfhi(v.x) * rk * g1[1] * g2[1]); o.y = cvtpk(bflo(v.y) * rk * g1[2] * g2[2], bfhi(v.y) * rk * g1[3] * g2[3]);
                *p = o;
            }
        }
        {
            PHASE_VARS;
            volatile LAS int* misc = (volatile LAS int*)(lds + MISC_OFF);
            const float* gret = A->in[4] + l * 512;
            for (int u = bx; u < 256; u += G) { const int bb = u & 7, idx = u >> 3, hh = idx >> 3, qb = idx & 7; attn_unit<128, false>(lds, P_R1, bb, hh, qb, log2f(1.0f - exp2f(-5.0f - (float)hh)), gret, nullptr); }
            for (;;) {
                if (tid == 0) misc[0] = atomicAdd(P_CTR + l, 1);
                __syncthreads();
                const int u = misc[0];
                __syncthreads();
                if (u >= 512) break;
                const int qb = 7 - (u >> 6), j = u & 63; sb_unit(lds, P_R1, j >> 3, j & 7, qb, P_QPART);
            }
        }
        GRID_SYNC();
        {
            PHASE_VARS;
            pg8::Gemm g{P_R1 + 2048, P_WL(l) + WO_MIX / 2, T_TOK, DM, DM, INC, 8, -5120l, P_QPART}; pg8::StaticOrder S; S.init(T_TOK, DM, G, bx);
            pg8::EpiRes<false> E{nullptr, P_XB, P_XSS(3 * l + 1)};
            if (G >= 256) {
                pg8::Unit u0;
                if (S.next(0, u0) && tid < 256) { const float* hp = P_QPART + (size_t)(u0.pm * 256 + tid) * 8; const f32x4 s0 = *(const f32x4*)hp, s1 = *(const f32x4*)(hp + 4);
                    ((LAS float*)(lds + MISC_OFF + 1024))[tid] = rsqrtf((((s0[0] + s0[1]) + (s0[2] + s0[3])) + ((s1[0] + s1[1]) + (s1[2] + s1[3]))) * (1.0f / 512.0f) + EPS); }
                __syncthreads();
                pg8::gemm_phase<2>(lds, g, S, E);
            } else pg8::gemm_phase<1>(lds, g, S, E);
        }
        GRID_SYNC();
        {
            PHASE_VARS;
            pg8::Gemm g{P_XB, P_WL(l) + WO_XQ / 2, T_TOK, DM, DM, DM, 1 << 30, 0l, nullptr}; pg8::StaticOrder S; S.init(T_TOK, DM, G, bx);
            pg8::EpiB<pg8::EM_Q> E{P_R1, DM, P_XSS(3 * l + 1), P_QPART};
            pg8::gemm_phase(lds, g, S, E);
        }
        {
            PHASE_VARS;
            __syncthreads();
            pg8::StaticOrder S; S.init(T_TOK, DM, G, bx); pg8::Unit u;
            for (int i = 0; S.next(i, u); ++i) xattn_unit(lds, P_R1, P_KV, P_QPART, P_O, u.pm >> 3, u.pn, u.pm & 7);
        }
        GRID_SYNC();
        {
            PHASE_VARS;
            pg8::Gemm g{P_O, P_WL(l) + WO_XO / 2, T_TOK, DM, DM, DM, 1 << 30, 0l, nullptr}; pg8::StaticOrder S; S.init(T_TOK, DM, G, bx);
            pg8::EpiRes<false> E{nullptr, P_XB, P_XSS(3 * l + 2)};
            pg8::gemm_phase(lds, g, S, E);
        }
        GRID_SYNC();
        {
            PHASE_VARS;
            pg8::Gemm g{P_XB, P_WL(l) + WO_UP / 2, T_TOK, FF, DM, DM, 1 << 30, 0l, nullptr}; pg8::StaticOrder S; S.init(T_TOK, FF, G, bx);
            g.pub = (int*)(ws + WS_PUB) + l * 4096;
            pg8::EpiB<pg8::EM_UP> E{P_R1, FF, P_XSS(3 * l + 2), nullptr};
            pg8::gemm_phase<false, true>(lds, g, S, E);
        }
        {
            PHASE_VARS;
            {
                pg8::StaticOrder Sw; Sw.init(T_TOK, DM, G, bx); pg8::Unit uw;
                if (wave == 0) {
                    int* pub = (int*)(ws + WS_PUB) + l * 4096;
                    for (int i = 0; Sw.next(i, uw); ++i) {
                        unsigned spins = 0;
                        while (__builtin_amdgcn_readfirstlane(__hip_atomic_load(pub + 64 * uw.pm, __ATOMIC_RELAXED, __HIP_MEMORY_SCOPE_AGENT)) < 128) { __builtin_amdgcn_s_sleep(2); if (++spins > (1u << 22)) break; }
                    }
                    __builtin_amdgcn_fence(__ATOMIC_ACQUIRE, "agent");
                    asm volatile("s_waitcnt vmcnt(0)" ::: "memory");
                }
                __syncthreads();
            }
            pg8::Gemm g{P_R1, P_WL(l) + WO_DOWN / 2, T_TOK, DM, FF, FF, 1 << 30, 0l, nullptr}; pg8::StaticOrder S; S.init(T_TOK, DM, G, bx);
            if (l == 1) { pg8::EpiRes<true> E{A->out, P_XB, nullptr}; pg8::gemm_phase(lds, g, S, E); }
            else { pg8::EpiRes<false> E{nullptr, P_XB, P_XSS(3 * l + 3)}; pg8::gemm_phase(lds, g, S, E); }
        }
        if (l == 0) GRID_SYNC();
    }
}

extern "C" void kernel_launch(void* const* d_in, const int* in_sizes, int n_in, void* d_out, int out_size, void* d_ws, size_t ws_size, hipStream_t stream) {
    static int grid = 0;
    if (grid == 0) {
        if (n_in != 17 || ws_size < WS_END) { fprintf(stderr, "kernel_launch: unexpected n_in %d / ws_size %zu\n", n_in, ws_size); grid = -1; return; }
        int dev = 0, cus = 0, per_cu = 0;
        hipGetDevice(&dev);
        hipDeviceGetAttribute(&cus, hipDeviceAttributeMultiprocessorCount, dev);
        hipFuncSetAttribute((const void*)hymba_fwd, hipFuncAttributeMaxDynamicSharedMemorySize, LDS_BYTES);
        hipOccupancyMaxActiveBlocksPerMultiprocessor(&per_cu, (const void*)hymba_fwd, 512, LDS_BYTES);
        if (per_cu < 1) { fprintf(stderr, "kernel_launch: occupancy query reports %d blocks per CU\n", per_cu); per_cu = 1; }
        grid = cus;
    }
    if (grid < 0) return;
    if (hipMemsetAsync((char*)d_ws + WS_CTR, 0, WS_CTL_BYTES, stream) != hipSuccess) { fprintf(stderr, "kernel_launch: memset of control words failed\n"); return; }
    Args a{};
    for (int i = 0; i < 17; ++i) a.in[i] = (const float*)d_in[i];
    a.out = (float*)d_out; a.ws = (unsigned char*)d_ws;
    void* args[] = {&a};
    hipError_t e = hipLaunchCooperativeKernel((const void*)hymba_fwd, dim3(grid), dim3(512), args, LDS_BYTES, stream);
    if (e != hipSuccess) fprintf(stderr, "cooperative launch failed: %s (grid %d)\n", hipGetErrorString(e), grid);
}
```
